# Optimizing an MI355X kernel written in HIP

```python
import math
import jax, jax.numpy as jnp
from jax import lax
import numpy as np

D_MODEL = 1024
BATCH = 4
SEQ = 8192
DEPTH = 1

D_A = D_MODEL
D_B = D_MODEL
D_MIX = D_A + D_B
N_GROUPS_A = 8
N_HEADS_B = 8
HEAD_DIM_B = D_B // N_HEADS_B
CHUNK = 128
SHORT_CONV = 3
FILTER_EMB = 33
FILTER_HIDDEN = 64
DECAY_TARGET = 1e-2
FAST_DECAY_PCT = 0.3
SLOW_DECAY_PCT = 1.5
D_IN = 4 * D_A + 3 * D_B
EPS = 1e-6

kernel_name = "hyena_gmlp_parallel_hybrid_block"


def rms_norm(x, w):
    xf = x.astype(jnp.float32)
    y = xf * lax.rsqrt(jnp.mean(xf * xf, axis=-1, keepdims=True) + EPS)
    return (y * w.astype(jnp.float32)).astype(x.dtype)


def short_conv_centred(u, w, b):
    up = jnp.pad(u, ((0, 0), (1, 1), (0, 0)))
    return up[:, :-2] * w[0] + up[:, 1:-1] * w[1] + up[:, 2:] * w[2] + b


def hyena_pos_features(L):
    bands = (FILTER_EMB - 1) // 2
    t = jnp.linspace(0.0, 1.0, L, dtype=jnp.float32)[:, None]
    w = 2.0 * math.pi * jnp.arange(L, dtype=jnp.float32)[:, None] / L
    f = jnp.linspace(1e-4, bands - 1, bands, dtype=jnp.float32)[None, :]
    return jnp.concatenate([t, jnp.cos(f * w), -jnp.sin(f * w)], axis=-1), t


def hyena_filter(L, w1, b1, fr1, w2, b2, fr2, w3, b3, fr3, w_o):
    f32 = jnp.float32
    z, t = hyena_pos_features(L)
    h = jnp.sin(fr1.astype(f32) * (z @ w1.astype(f32) + b1.astype(f32)))
    h = jnp.sin(fr2.astype(f32) * (h @ w2.astype(f32) + b2.astype(f32)))
    h = jnp.sin(fr3.astype(f32) * (h @ w3.astype(f32) + b3.astype(f32)))
    h = h @ w_o.astype(f32)
    deltas = jnp.abs(jnp.linspace(math.log(DECAY_TARGET) / SLOW_DECAY_PCT,
                                  math.log(DECAY_TARGET) / FAST_DECAY_PCT,
                                  D_A, dtype=f32))
    decay = jnp.exp(-t * deltas[None, :])
    h_fwd = h[:, :D_A] * decay
    h_bwd = h[:, D_A:] * decay
    l1 = jnp.sum(jnp.abs(h_fwd), axis=0) + jnp.sum(jnp.abs(h_bwd[1:]), axis=0)
    k = jnp.concatenate([h_fwd, jnp.zeros((1, D_A), f32), h_bwd[1:][::-1]], axis=0)
    return k / (l1[None, :] + EPS)


def long_conv_bidir(u, k, skip):
    L = u.shape[1]
    uf = u.astype(jnp.float32)
    U = jnp.fft.rfft(uf, n=2 * L, axis=1)
    K = jnp.fft.rfft(k, axis=0)
    y = jnp.fft.irfft(U * K[None], n=2 * L, axis=1)[:, :L]
    return (y + uf * skip.astype(jnp.float32)).astype(u.dtype)


def setup_inputs(seed: int = 0) -> dict:
    key = jax.random.key(seed)
    ks = jax.random.split(key, 24)
    n = jax.random.normal
    f32 = jnp.float32
    return {
        "x": n(ks[0], (BATCH, SEQ, D_MODEL), f32),
        "pre_norm_w": 1.0 + 0.05 * n(ks[1], (D_MODEL,), f32),
        "w_in": n(ks[2], (D_MODEL, D_IN), f32) * D_MODEL ** -0.5,
        "conv_w": n(ks[3], (SHORT_CONV, 3 * D_A), f32) * SHORT_CONV ** -0.5,
        "conv_b": 0.01 * n(ks[4], (3 * D_A,), f32),
        "filt_w1": n(ks[5], (FILTER_EMB, FILTER_HIDDEN), f32) * FILTER_EMB ** -0.5,
        "filt_b1": 0.1 * n(ks[6], (FILTER_HIDDEN,), f32),
        "filt_freq1": 1.0 + 0.05 * n(ks[7], (FILTER_HIDDEN,), f32),
        "filt_w2": n(ks[8], (FILTER_HIDDEN, FILTER_HIDDEN), f32) * FILTER_HIDDEN ** -0.5,
        "filt_b2": 0.1 * n(ks[9], (FILTER_HIDDEN,), f32),
        "filt_freq2": 1.0 + 0.05 * n(ks[10], (FILTER_HIDDEN,), f32),
        "filt_w3": n(ks[11], (FILTER_HIDDEN, FILTER_HIDDEN), f32) * FILTER_HIDDEN ** -0.5,
        "filt_b3": 0.1 * n(ks[12], (FILTER_HIDDEN,), f32),
        "filt_freq3": 1.0 + 0.05 * n(ks[13], (FILTER_HIDDEN,), f32),
        "filt_w_out": n(ks[14], (FILTER_HIDDEN, 2 * D_A), f32) * FILTER_HIDDEN ** -0.5,
        "hyena_skip": 0.1 * n(ks[15], (D_A,), f32),
        "sgu_norm_w": 1.0 + 0.05 * n(ks[16], (D_B,), f32),
        "sgu_norm_b": 0.01 * n(ks[17], (D_B,), f32),
        "sgu_w": n(ks[18], (N_HEADS_B, CHUNK, CHUNK), f32) * CHUNK ** -0.5,
        "sgu_b": 1.0 + 0.05 * n(ks[19], (N_HEADS_B, CHUNK), f32),
        "w_out": n(ks[20], (D_MIX, D_MODEL), f32) * D_MIX ** -0.5,
        "post_norm_w": 1.0 + 0.05 * n(ks[21], (D_MODEL,), f32),
    }


def reference(x, pre_norm_w, w_in, conv_w, conv_b, filt_w1, filt_b1, filt_freq1,
              filt_w2, filt_b2, filt_freq2, filt_w3, filt_b3, filt_freq3, filt_w_out,
              hyena_skip, sgu_norm_w, sgu_norm_b, sgu_w, sgu_b, w_out, post_norm_w):
    B, L, _ = x.shape
    for _layer in range(DEPTH):
        h = rms_norm(x, pre_norm_w)
        proj = h @ w_in
        hy_in, hy_gate, sg_u, sg_v, sg_gate = jnp.split(
            proj, [3 * D_A, 4 * D_A, 4 * D_A + D_B, 4 * D_A + 2 * D_B], axis=-1)

        hy_in = short_conv_centred(hy_in, conv_w, conv_b)
        x0, x1, v = jnp.split(hy_in, 3, axis=-1)
        k = hyena_filter(L, filt_w1, filt_b1, filt_freq1, filt_w2, filt_b2, filt_freq2,
                         filt_w3, filt_b3, filt_freq3, filt_w_out)
        y_a = x0 * long_conv_bidir(v * x1, k, hyena_skip)
        y_a = y_a * jax.nn.silu(hy_gate)

        vf = sg_v.astype(jnp.float32).reshape(B, L, N_HEADS_B, HEAD_DIM_B)
        mu = jnp.mean(vf, axis=-1, keepdims=True)
        var = jnp.mean(jnp.square(vf - mu), axis=-1, keepdims=True)
        vn = ((vf - mu) * lax.rsqrt(var + EPS)
              * sgu_norm_w.astype(jnp.float32).reshape(N_HEADS_B, HEAD_DIM_B)
              + sgu_norm_b.astype(jnp.float32).reshape(N_HEADS_B, HEAD_DIM_B)).astype(x.dtype)
        vc = vn.reshape(B, L // CHUNK, CHUNK, N_HEADS_B, HEAD_DIM_B)
        mixed = jnp.einsum('hpq,bnqhd->bnphd', sgu_w, vc) \
            + jnp.transpose(sgu_b)[None, None, :, :, None]
        y_b = sg_u * mixed.reshape(B, L, D_B) * jax.nn.silu(sg_gate)

        y = jnp.concatenate([y_a, y_b], axis=-1) @ w_out
        x = x + rms_norm(y, post_norm_w)
    return x
```

```cpp
#include <hip/hip_runtime.h>
#include <hip/hip_cooperative_groups.h>
#include <cstdio>
#include <cstdint>
namespace cg = cooperative_groups;

#define HD __host__ __device__ __forceinline__
struct __attribute__((aligned(8))) cf { float x, y; };
constexpr int FFT_N = 16384;
constexpr int FFT_LDS_CF = FFT_N + (FFT_N >> 5) * 2;
HD int PADI(int i) { return i + ((i >> 5) << 1); }
HD cf cadd(cf a, cf b) { return cf{a.x + b.x, a.y + b.y}; }
HD cf csub(cf a, cf b) { return cf{a.x - b.x, a.y - b.y}; }
HD cf cmul(cf a, cf b) { return cf{a.x * b.x - a.y * b.y, a.x * b.y + a.y * b.x}; }
template <bool INV> HD cf twc(cf a, float c, float s) { return INV ? cf{a.x * c - a.y * s, a.x * s + a.y * c} : cf{a.x * c + a.y * s, a.y * c - a.x * s}; }
template <bool INV> HD cf mul_mi(cf a) { return INV ? cf{-a.y, a.x} : cf{a.y, -a.x}; }
template <bool INV> HD void dft4(cf& a0, cf& a1, cf& a2, cf& a3) {
    const cf t0 = cadd(a0, a2), t1 = csub(a0, a2), t2 = cadd(a1, a3), t3 = mul_mi<INV>(csub(a1, a3));
    a0 = cadd(t0, t2); a2 = csub(t0, t2); a1 = cadd(t1, t3); a3 = csub(t1, t3);
}
template <int R> HD constexpr int KIDX(int j) { return R == 16 ? ((j >> 2) + 4 * (j & 3)) : ((j >> 1) + 4 * (j & 1)); }
template <int R> HD constexpr int JIDX(int k) { return R == 16 ? ((k >> 2) + 4 * (k & 3)) : (2 * (k & 3) + (k >> 2)); }
template <bool INV> HD void dft8(cf (&a)[8]) {
    dft4<INV>(a[0], a[2], a[4], a[6]);
    dft4<INV>(a[1], a[3], a[5], a[7]);
    const float c = 0.70710678118654752f;
    a[3] = twc<INV>(a[3], c, c);
    a[5] = mul_mi<INV>(a[5]);
    a[7] = twc<INV>(a[7], -c, c);
#pragma unroll
    for (int k = 0; k < 4; ++k) { const cf e = a[2 * k], o = a[2 * k + 1]; a[2 * k] = cadd(e, o); a[2 * k + 1] = csub(e, o); }
}
template <bool INV> HD void dft16(cf (&a)[16]) {
#pragma unroll
    for (int s = 0; s < 4; ++s) dft4<INV>(a[s], a[s + 4], a[s + 8], a[s + 12]);
    const float c1 = 0.92387953251128674f, s1 = 0.38268343236508977f, c2 = 0.70710678118654752f;
    a[1 + 4] = twc<INV>(a[1 + 4], c1, s1);
    a[2 + 4] = twc<INV>(a[2 + 4], c2, c2);
    a[3 + 4] = twc<INV>(a[3 + 4], s1, c1);
    a[1 + 8] = twc<INV>(a[1 + 8], c2, c2);
    a[2 + 8] = mul_mi<INV>(a[2 + 8]);
    a[3 + 8] = twc<INV>(a[3 + 8], -c2, c2);
    a[1 + 12] = twc<INV>(a[1 + 12], s1, c1);
    a[2 + 12] = twc<INV>(a[2 + 12], -c2, c2);
    a[3 + 12] = twc<INV>(a[3 + 12], -c1, -s1);
#pragma unroll
    for (int k1 = 0; k1 < 4; ++k1) dft4<INV>(a[4 * k1], a[4 * k1 + 1], a[4 * k1 + 2], a[4 * k1 + 3]);
}
template <int R, bool INV> HD void dftR(cf (&a)[R]) { if constexpr (R == 16) dft16<INV>(a); else dft8<INV>(a); }
template <int R, bool INV, int S, int TWS, class XP, class TP>
HD void fft_stage(XP X, TP tw, int tid, int nthreads) {
    constexpr int NB = FFT_N / R;
    for (int g = tid; g < NB; g += nthreads) {
        const int np = g & (S - 1);
        const int base = (g - np) * R + np;
        cf a[R];
#pragma unroll
        for (int j = 0; j < R; ++j) a[j] = X[PADI(base + j * S)];
        cf w = cf{1.f, 0.f};
        if constexpr (TWS != 0) { w = tw[np * TWS]; if (INV) w.y = -w.y; }
        if constexpr (INV && TWS != 0) {
            cf p = w;
#pragma unroll
            for (int j = 1; j < R; ++j) { a[j] = cmul(a[j], p); p = cmul(p, w); }
        }
        dftR<R, INV>(a);
        if constexpr (!INV && TWS != 0) {
            cf p = w;
#pragma unroll
            for (int k = 1; k < R; ++k) { a[JIDX<R>(k)] = cmul(a[JIDX<R>(k)], p); p = cmul(p, w); }
        }
#pragma unroll
        for (int j = 0; j < R; ++j) X[PADI(base + KIDX<R>(j) * S)] = a[j];
    }
}
namespace pg8 {
#define PG8_LAS __attribute__((address_space(3)))
typedef unsigned short bf16_t;
typedef short bf16x8 __attribute__((ext_vector_type(8)));
typedef float f32x4 __attribute__((ext_vector_type(4)));
typedef unsigned u32x4 __attribute__((ext_vector_type(4)));
constexpr int BM = 256, BK = 64, HALF = 128, HTB = HALF * BK * 2  , STAGE_BYTES = 8 * HTB, NXCD = 8, WGM = 8;

__host__ __device__ __forceinline__ int lds_byte(int r, int c) { const int st = (r >> 4) * 2 + (c >> 5), rr = r & 15, cc = c & 31, ob = rr * 64 + cc * 2; return st * 1024 + (ob ^ (((ob >> 9) & 1) << 5)); }
__host__ __device__ __forceinline__ void stage_rc(int b, int& R, int& C) { const int st = b / 1024, sb = b % 1024, swz = sb ^ (((sb >> 9) & 1) << 5); R = (st >> 1) * 16 + swz / 64; C = (st & 1) * 32 + (swz % 64) / 2; }
__host__ __device__ __forceinline__ int perm32(int rho) { const int n = rho >> 4, i = rho & 15; return 8 * (i >> 2) + 4 * n + (i & 3); }

struct Unit { int pm, pn; };
struct Gemm { const bf16_t* A; const bf16_t* Bt; int M, N, K, lda; };

struct StaticOrder {
    int nM, nN, nwg, G, c;
    __host__ __device__ void init(int M, int N, int G_, int c_) { nM = M / BM; nN = N / BM; nwg = nM * nN; G = G_; c = c_; }
    __host__ __device__ bool next(int i, Unit& u) const {
        const long L = (long)i * G + c; if (L >= nwg) return false;
        int wgid = (int)L; { const int q = nwg / NXCD, r = nwg % NXCD, xcd = wgid % NXCD, off = wgid / NXCD; wgid = (xcd < r ? xcd * (q + 1) : r * (q + 1) + (xcd - r) * q) + off; }
        const int nig = WGM * nN, gid = wgid / nig, fm = gid * WGM, gsz = (nM - fm) < WGM ? (nM - fm) : WGM;
        u.pm = fm + ((wgid % nig) % gsz); u.pn = (wgid % nig) / gsz; return true;
    }
    __device__ __forceinline__ void a_ready(const Unit&) const {}
    __device__ __forceinline__ void done(const Unit&) const {}
};
__device__ __forceinline__ unsigned cvt_pk_bf16(float lo, float hi) { unsigned r; asm volatile("v_cvt_pk_bf16_f32 %0, %1, %2" : "=v"(r) : "v"(lo), "v"(hi)); return r; }
typedef float f32x2 __attribute__((ext_vector_type(2)));
__device__ __forceinline__ f32x2 gelu_pk(f32x2 v) {
    const f32x2 av = __builtin_elementwise_abs(v), d = av * 0.2316418882f + 1.0f;
    f32x2 t; t.x = __builtin_amdgcn_rcpf(d.x); t.y = __builtin_amdgcn_rcpf(d.y);
    f32x2 q = t * 0.5307027145f + (-0.7265760135f); q = q * t + 0.7107068705f; q = q * t + (-0.142248368f); q = q * t + 0.127414796f; q = q * t;
    const f32x2 s = (v * v) * (-0.72134752044f);
    f32x2 e; e.x = __builtin_amdgcn_exp2f(s.x); e.y = __builtin_amdgcn_exp2f(s.y);
    const f32x2 m = v * (q * e), r = v - m;
    f32x2 o; o.x = v.x < 0.f ? m.x : r.x; o.y = v.y < 0.f ? m.y : r.y; return o;
}

struct EpiF32 {
    static constexpr bool PERM = false, AFTER_DRAIN = false, SWAP = false;
    float* C; int ldc; const float* bias;
    __device__ __forceinline__ void operator()(const f32x4 (&acc)[2][2][4][2], const Unit& u, int wr, int wc, int fr, int fq) const {
        const int row0 = u.pm * BM + wr * 64 + fr, col0 = u.pn * BM + wc * 32 + 4 * fq;
        f32x4 bv[2][2];
#pragma unroll
        for (int bj = 0; bj < 2; ++bj)
#pragma unroll
            for (int n = 0; n < 2; ++n) bv[bj][n] = bias ? *(const f32x4*)(bias + col0 + bj * HALF + n * 16) : (f32x4){0.f, 0.f, 0.f, 0.f};
#pragma unroll
        for (int ai = 0; ai < 2; ++ai)
#pragma unroll
            for (int m = 0; m < 4; ++m) { float* rowp = C + (size_t)(row0 + ai * HALF + m * 16) * ldc + col0;
#pragma unroll
                for (int bj = 0; bj < 2; ++bj)
#pragma unroll
                    for (int n = 0; n < 2; ++n) *(f32x4*)(rowp + bj * HALF + n * 16) = acc[ai][bj][m][n] + bv[bj][n]; }
    }
};
template <int ACT  > struct EpiBf16 {
    static constexpr bool PERM = true, AFTER_DRAIN = false, SWAP = false;
    bf16_t* O; int ldc; const float* bias; int split_cols; size_t split_stride;
    __device__ __forceinline__ void operator()(const f32x4 (&acc)[2][2][4][2], const Unit& u, int wr, int wc, int fr, int fq) const {
        const int row0 = u.pm * BM + wr * 64 + fr; int colt = u.pn * BM; bf16_t* base = O;
        if (split_cols) { const int t = colt / split_cols; base += (size_t)t * split_stride; colt -= t * split_cols; }
        const int col0 = colt + wc * 32 + 8 * fq, bcol0 = u.pn * BM + wc * 32 + 8 * fq;
        f32x4 bv[2][2];
#pragma unroll
        for (int bj = 0; bj < 2; ++bj)
#pragma unroll
            for (int n = 0; n < 2; ++n) bv[bj][n] = bias ? *(const f32x4*)(bias + bcol0 + bj * HALF + 4 * n) : (f32x4){0.f, 0.f, 0.f, 0.f};
#pragma unroll
        for (int ai = 0; ai < 2; ++ai)
#pragma unroll
            for (int m = 0; m < 4; ++m) { bf16_t* rowp = base + (size_t)(row0 + ai * HALF + m * 16) * ldc + col0;
#pragma unroll
                for (int bj = 0; bj < 2; ++bj) { f32x4 v0 = acc[ai][bj][m][0] + bv[bj][0], v1 = acc[ai][bj][m][1] + bv[bj][1];
                    if (ACT == 1) { f32x2 a = gelu_pk((f32x2){v0[0], v0[1]}), b = gelu_pk((f32x2){v0[2], v0[3]}), c = gelu_pk((f32x2){v1[0], v1[1]}), d = gelu_pk((f32x2){v1[2], v1[3]});
                        v0 = (f32x4){a.x, a.y, b.x, b.y}; v1 = (f32x4){c.x, c.y, d.x, d.y}; }
                    if (ACT == 2) {
#pragma unroll
                        for (int j = 0; j < 4; ++j) { v0[j] = 0.5f * v0[j] * (1.0f + erff(v0[j] * 0.70710678f)); v1[j] = 0.5f * v1[j] * (1.0f + erff(v1[j] * 0.70710678f)); } }
                    u32x4 w; w.x = cvt_pk_bf16(v0[0], v0[1]); w.y = cvt_pk_bf16(v0[2], v0[3]); w.z = cvt_pk_bf16(v1[0], v1[1]); w.w = cvt_pk_bf16(v1[2], v1[3]);
                    *(u32x4*)(rowp + bj * HALF) = w; } }
    }
};
template <class Epi, class Sched, bool STAMP = false>
__device__ __forceinline__ void gemm_phase(PG8_LAS unsigned char* lds, const Gemm g, const Sched& S, const Epi& E, unsigned long long* stamps) {
    const int tid = threadIdx.x, wid = __builtin_amdgcn_readfirstlane(tid >> 6), lane = tid & 63, wr = wid >> 2, wc = wid & 3, fr = lane & 15, fq = lane >> 4;
    const int K = g.K, nt = K / BK;
    int ts_lo = 0, ts_hi = 0, nts = 0; const unsigned long long rt_entry = STAMP ? (unsigned long long)wall_clock64() : 0ull;
#define PG8_STAMP() do { if (STAMP && wid == 0 && nts < 64) { const unsigned long long _c = (unsigned long long)clock64(); \
        ts_lo = (lane == nts) ? (int)(unsigned)_c : ts_lo; ts_hi = (lane == nts) ? (int)(unsigned)(_c >> 32) : ts_hi; ++nts; } } while (0)
    PG8_STAMP();
    unsigned voffA[2], voffB[2];
#pragma unroll
    for (int i = 0; i < 2; ++i) { int R, C; stage_rc(tid * 16 + i * 8192, R, C); const int Rb = Epi::PERM ? ((R & ~31) + perm32(R & 31)) : R;
        voffA[i] = (unsigned)(R * g.lda + C) * 2u; voffB[i] = (unsigned)(Rb * K + C) * 2u; }
    const size_t kstep = (size_t)(BK * 2);
    const size_t hstepA = (size_t)HALF * g.lda * 2, hstepB = (size_t)HALF * K * 2;
    const size_t tstepA = 2 * hstepA, tstepB = 2 * hstepB;
    const unsigned ldsw = (unsigned)wid * 1024u;
    const int aoff = lds_byte(wr * 64 + fr, fq * 8), boff = lds_byte(wc * 32 + fr, fq * 8);
#define PG8_SA(b, h) (((b) * 2 + (h)) * HTB)
#define PG8_SB(b, h) ((4 + (b) * 2 + (h)) * HTB)
#define PG8_STAGE(bufoff, gbase, voff) do { _Pragma("unroll") for (int _i = 0; _i < 2; ++_i) \
        __builtin_amdgcn_global_load_lds((const unsigned*)((const char*)(gbase) + (voff)[_i]), (PG8_LAS unsigned*)(lds + (bufoff) + ldsw + _i * 8192), 16, 0, 0); } while (0)
#define PG8_LDA(dst, b, h) do { _Pragma("unroll") for (int m = 0; m < 4; ++m) _Pragma("unroll") for (int k = 0; k < 2; ++k) dst[m][k] = *(const PG8_LAS bf16x8*)(lds + PG8_SA(b, h) + aoff + m * 2048 + k * 1024); } while (0)
#define PG8_LDB(dst, b, h) do { _Pragma("unroll") for (int n = 0; n < 2; ++n) _Pragma("unroll") for (int k = 0; k < 2; ++k) dst[n][k] = *(const PG8_LAS bf16x8*)(lds + PG8_SB(b, h) + boff + n * 2048 + k * 1024); } while (0)
#define PG8_MMA(ai, bj, At, Bt) do { __builtin_amdgcn_s_setprio(1); _Pragma("unroll") for (int m = 0; m < 4; ++m) _Pragma("unroll") for (int n = 0; n < 2; ++n) _Pragma("unroll") for (int k = 0; k < 2; ++k) \
        acc[ai][bj][m][n] = Epi::SWAP ? __builtin_amdgcn_mfma_f32_16x16x32_bf16(At[m][k], Bt[n][k], acc[ai][bj][m][n], 0, 0, 0) : __builtin_amdgcn_mfma_f32_16x16x32_bf16(Bt[n][k], At[m][k], acc[ai][bj][m][n], 0, 0, 0); __builtin_amdgcn_s_setprio(0); } while (0)
#define PG8_WAIT_V(n) asm volatile("s_waitcnt vmcnt(" #n ")" ::: "memory")
#define PG8_WAIT_L(n) asm volatile("s_waitcnt lgkmcnt(" #n ")" ::: "memory")
#define PG8_BAR __builtin_amdgcn_s_barrier()
#define PG8_SCHED __builtin_amdgcn_sched_barrier(0)
    Unit cur, nxt; int ui = 0;
    if (!S.next(0, cur)) return;
    f32x4 acc[2][2][4][2];
#pragma unroll
    for (int a = 0; a < 2; ++a)
#pragma unroll
        for (int b = 0; b < 2; ++b)
#pragma unroll
            for (int m = 0; m < 4; ++m)
#pragma unroll
                for (int n = 0; n < 2; ++n) acc[a][b][m][n] = (f32x4){0.f, 0.f, 0.f, 0.f};
    bf16x8 At[4][2], B0[2][2], B1[2][2];
    const char* cA = (const char*)g.A + (size_t)cur.pm * tstepA; const char* cB = (const char*)g.Bt + (size_t)cur.pn * tstepB;
    S.a_ready(cur);
    PG8_STAGE(PG8_SB(0, 0), cB, voffB); PG8_STAGE(PG8_SA(0, 0), cA, voffA); PG8_STAGE(PG8_SB(0, 1), cB + hstepB, voffB); PG8_STAGE(PG8_SA(0, 1), cA + hstepA, voffA);
    if (wr == 1) PG8_BAR;
    PG8_WAIT_V(4); PG8_BAR;
    PG8_STAGE(PG8_SB(1, 0), cB + kstep, voffB); PG8_STAGE(PG8_SA(1, 0), cA + kstep, voffA); PG8_STAGE(PG8_SB(1, 1), cB + hstepB + kstep, voffB);
    PG8_WAIT_V(6); PG8_BAR;
    PG8_STAMP();
    for (;;) {
        const bool has_next = S.next(ui + 1, nxt);
        const char* nA = has_next ? (const char*)g.A + (size_t)nxt.pm * tstepA : cA; const char* nB = has_next ? (const char*)g.Bt + (size_t)nxt.pn * tstepB : cB;
        for (int t = 0; t < nt; t += 2) {
            const bool last = (t == nt - 2);
            const char* a1 = cA + (size_t)(t + 1) * kstep;
            const char* a2 = last ? nA : cA + (size_t)(t + 2) * kstep; const char* b2 = last ? nB : cB + (size_t)(t + 2) * kstep;
            const char* a3 = a2 + kstep; const char* b3 = b2 + kstep;
            if (last && has_next) S.a_ready(nxt);
            PG8_LDB(B0, 0, 0); PG8_SCHED; PG8_LDA(At, 0, 0); PG8_STAGE(PG8_SA(1, 1), a1 + hstepA, voffA);
            PG8_WAIT_L(8); PG8_BAR; PG8_WAIT_L(0); PG8_MMA(0, 0, At, B0); PG8_BAR; PG8_SCHED;
            PG8_LDB(B1, 0, 1); PG8_STAGE(PG8_SB(0, 0), b2, voffB);
            PG8_BAR; PG8_WAIT_L(0); PG8_MMA(0, 1, At, B1); PG8_BAR;
            PG8_LDA(At, 0, 1); PG8_STAGE(PG8_SA(0, 0), a2, voffA);
            PG8_BAR; PG8_WAIT_L(0); PG8_MMA(1, 0, At, B0); PG8_BAR; PG8_SCHED;
            PG8_STAGE(PG8_SB(0, 1), b2 + hstepB, voffB);
            PG8_WAIT_V(6); PG8_BAR; PG8_MMA(1, 1, At, B1); PG8_BAR;
            PG8_LDB(B0, 1, 0); PG8_SCHED; PG8_LDA(At, 1, 0); PG8_STAGE(PG8_SA(0, 1), a2 + hstepA, voffA);
            PG8_WAIT_L(8); PG8_BAR; PG8_WAIT_L(0); PG8_MMA(0, 0, At, B0); PG8_BAR; PG8_SCHED;
            PG8_LDB(B1, 1, 1); PG8_STAGE(PG8_SB(1, 0), b3, voffB);
            PG8_BAR; PG8_WAIT_L(0); PG8_MMA(0, 1, At, B1); PG8_BAR;
            PG8_LDA(At, 1, 1); PG8_STAGE(PG8_SA(1, 0), a3, voffA);
            PG8_BAR; PG8_WAIT_L(0); PG8_MMA(1, 0, At, B0); PG8_BAR; PG8_SCHED;
            PG8_STAGE(PG8_SB(1, 1), b3 + hstepB, voffB);
            PG8_WAIT_V(6); PG8_BAR; PG8_MMA(1, 1, At, B1); PG8_BAR;
        }
        PG8_STAMP();
        if constexpr (!Epi::AFTER_DRAIN) { E(acc, cur, wr, wc, fr, fq); S.done(cur); }
        PG8_STAMP();
        if (!has_next) break;
#pragma unroll
        for (int a = 0; a < 2; ++a)
#pragma unroll
            for (int b = 0; b < 2; ++b)
#pragma unroll
                for (int m = 0; m < 4; ++m)
#pragma unroll
                    for (int n = 0; n < 2; ++n) acc[a][b][m][n] = (f32x4){0.f, 0.f, 0.f, 0.f};
        cur = nxt; cA = nA; cB = nB; ++ui;
    }
    PG8_WAIT_V(0);
    if (wr == 0) PG8_BAR;
    PG8_BAR;
    if constexpr (Epi::AFTER_DRAIN) { E.fused(acc, cur, wr, wc, fr, fq, lds, wid, lane); S.done(cur); }
    PG8_STAMP();
    if (STAMP && wid == 0) { stamps[lane] = lane < nts ? (((unsigned long long)(unsigned)ts_hi << 32) | (unsigned)ts_lo) : 0ull;
        if (lane == 62) stamps[62] = rt_entry; if (lane == 63) stamps[63] = (unsigned long long)wall_clock64(); }
#undef PG8_STAMP
#undef PG8_SA
#undef PG8_SB
#undef PG8_STAGE
#undef PG8_LDA
#undef PG8_LDB
#undef PG8_MMA
#undef PG8_WAIT_V
#undef PG8_WAIT_L
#undef PG8_BAR
#undef PG8_SCHED
}
}

constexpr int NT = 512;
constexpr int BATCH = 4, SEQ = 8192, DM = 1024, MTOK = BATCH * SEQ, DIN = 7168, NHY = 4096, NSG = 3072;
constexpr float EPSF = 1e-6f;
constexpr size_t MiB = 1024ull * 1024ull;
constexpr size_t WS_W1T = 0;
constexpr size_t WS_W2T = WS_W1T + 14 * MiB;
constexpr size_t WS_TW = WS_W2T + 4 * MiB;
constexpr size_t WS_SGW = WS_TW + 64 * 1024;
constexpr size_t WS_KSCR = WS_W2T + 5 * MiB;
constexpr size_t WS_HYT = WS_KSCR + 32 * MiB;
constexpr size_t WS_SG = WS_HYT + 256 * MiB;
constexpr size_t WS_END = WS_SG + 192 * MiB;
constexpr int LDS_BYTES = FFT_LDS_CF * 8 + 1024;

typedef unsigned short bf16_t;
typedef short bf16x8 __attribute__((ext_vector_type(8)));
typedef float f32x4 __attribute__((ext_vector_type(4)));

struct Params {
    const float* in[22];
    float* out;
    unsigned char* ws;
};

__device__ __forceinline__ unsigned pk_bf16(float lo, float hi) { unsigned r; asm volatile("v_cvt_pk_bf16_f32 %0, %1, %2" : "=v"(r) : "v"(lo), "v"(hi)); return r; }
__device__ __forceinline__ bf16_t f2bf(float f) { return (bf16_t)(pk_bf16(f, 0.f) & 0xffffu); }
__device__ __forceinline__ float bf_lo(unsigned u) { return __uint_as_float(u << 16); }
__device__ __forceinline__ float bf_hi(unsigned u) { return __uint_as_float(u & 0xffff0000u); }
__device__ __forceinline__ float bf2f(bf16_t b) { return __uint_as_float(((unsigned)b) << 16); }
__device__ __forceinline__ float siluf(float x) { return x / (1.0f + __expf(-x)); }
__device__ __forceinline__ float wave_sum(float v) {
#pragma unroll
    for (int o = 32; o >= 1; o >>= 1) v += __shfl_xor(v, o);
    return v;
}

__device__ __forceinline__ void transpose_tile(const float* src, int ldsrc, int k0, int n0, bf16_t* dst, int lddst, int kd0, unsigned char* lds) {
    bf16_t* T = (bf16_t*)lds;
    const int tid = threadIdx.x;
    { const int k = tid >> 3, nc = (tid & 7) * 8;
      const float4 a = *(const float4*)(src + (size_t)(k0 + k) * ldsrc + n0 + nc), b = *(const float4*)(src + (size_t)(k0 + k) * ldsrc + n0 + nc + 4);
      T[(nc + 0) * 72 + k] = f2bf(a.x); T[(nc + 1) * 72 + k] = f2bf(a.y); T[(nc + 2) * 72 + k] = f2bf(a.z); T[(nc + 3) * 72 + k] = f2bf(a.w);
      T[(nc + 4) * 72 + k] = f2bf(b.x); T[(nc + 5) * 72 + k] = f2bf(b.y); T[(nc + 6) * 72 + k] = f2bf(b.z); T[(nc + 7) * 72 + k] = f2bf(b.w); }
    __syncthreads();
    { const int n = tid >> 3, kc = (tid & 7) * 8;
      const uint4 v = *(const uint4*)(T + n * 72 + kc);
      *(uint4*)(dst + (size_t)(n0 + n) * lddst + kd0 + kc) = v; }
    __syncthreads();
}

__device__ __forceinline__ void filter_job(const Params& p, int job, unsigned char* lds) {
    float* Z = (float*)lds;
    float* HA = Z + 16 * 33 + 16;
    float* HB = HA + 16 * 64;
    const int tid = threadIdx.x, t0 = job * 16;
    const float* w1 = p.in[5]; const float* b1 = p.in[6]; const float* f1 = p.in[7];
    const float* w2 = p.in[8]; const float* b2 = p.in[9]; const float* f2 = p.in[10];
    const float* w3 = p.in[11]; const float* b3 = p.in[12]; const float* f3 = p.in[13];
    const float* wo = p.in[14];
    float* kraw = (float*)((unsigned char*)p.out + 64 * MiB);
    for (int e = tid; e < 16 * 33; e += NT) {
        const int r = e / 33, i = e % 33; const int t = t0 + r;
        const float tn = (float)t / (float)(SEQ - 1);
        float v;
        if (i == 0) v = tn;
        else {
            const int band = (i - 1) & 15;
            const float f = 1e-4f + (float)band * ((15.0f - 1e-4f) / 15.0f);
            const float a2 = 2.0f * f * ((float)t / (float)SEQ);
            v = (i <= 16) ? cospif(a2) : -sinpif(a2);
        }
        Z[r * 33 + i] = v;
    }
    __syncthreads();
    for (int e = tid; e < 16 * 64; e += NT) {
        const int r = e >> 6, j = e & 63; float s = b1[j];
#pragma unroll 4
        for (int i = 0; i < 33; ++i) s += Z[r * 33 + i] * w1[i * 64 + j];
        HA[r * 64 + j] = sinpif(f1[j] * s * 0.31830988618379067f);
    }
    __syncthreads();
    for (int e = tid; e < 16 * 64; e += NT) {
        const int r = e >> 6, j = e & 63; float s = b2[j];
#pragma unroll 4
        for (int i = 0; i < 64; ++i) s += HA[r * 64 + i] * w2[i * 64 + j];
        HB[r * 64 + j] = sinpif(f2[j] * s * 0.31830988618379067f);
    }
    __syncthreads();
    for (int e = tid; e < 16 * 64; e += NT) {
        const int r = e >> 6, j = e & 63; float s = b3[j];
#pragma unroll 4
        for (int i = 0; i < 64; ++i) s += HB[r * 64 + i] * w3[i * 64 + j];
        HA[r * 64 + j] = sinpif(f3[j] * s * 0.31830988618379067f);
    }
    __syncthreads();
    const float da = -3.0701134573253945f, db = -15.350567286626973f;
#pragma unroll 1
    for (int jj = 0; jj < 4; ++jj) {
        const int n = tid + jj * NT;
        float acc[16];
#pragma unroll
        for (int r = 0; r < 16; ++r) acc[r] = 0.f;
#pragma unroll 2
        for (int k = 0; k < 64; ++k) {
            const float w = wo[k * 2048 + n];
#pragma unroll
            for (int r = 0; r < 16; ++r) acc[r] += HA[r * 64 + k] * w;
        }
        const int c = n & 1023;
        const float delta = fabsf(da + (db - da) * ((float)c / 1023.0f));
#pragma unroll
        for (int r = 0; r < 16; ++r) { const float tn = (float)(t0 + r) / (float)(SEQ - 1); acc[r] *= expf(-tn * delta); }
        float* kr = kraw + (size_t)c * FFT_N;
        if (n < 1024) {
#pragma unroll
            for (int r = 0; r < 16; r += 4) *(float4*)(kr + t0 + r) = make_float4(acc[r], acc[r + 1], acc[r + 2], acc[r + 3]);
        } else {
#pragma unroll
            for (int r = 0; r < 16; ++r) { const int m = t0 + r; if (m == 0) kr[SEQ] = 0.f; else kr[FFT_N - m] = acc[r]; }
        }
    }
    __syncthreads();
}

__device__ __forceinline__ void phase0(const Params& p, unsigned char* lds) {
    const int tid = threadIdx.x, lane = tid & 63, wave = tid >> 6, G = gridDim.x, bid = blockIdx.x;
    bf16_t* W1T = (bf16_t*)(p.ws + WS_W1T); bf16_t* W2T = (bf16_t*)(p.ws + WS_W2T);
    for (int job = bid; job < SEQ / 16; job += G) filter_job(p, job, lds);
    for (int t = bid; t < 1792 + 512; t += G) {
        if (t < 1792) { const int kt = t & 15, nt = t >> 4; transpose_tile(p.in[2], DIN, kt * 64, nt * 64, W1T, DM, kt * 64, lds); }
        else { const int u = t - 1792, kt = u & 31, nt = u >> 5; const int k0 = kt * 64; transpose_tile(p.in[20], DM, k0, nt * 64, W2T, 2048, (k0 + 1024) & 2047, lds); }
    }
    { bf16_t* sgw = (bf16_t*)(p.ws + WS_SGW); const float* s = p.in[18];
      for (int i = bid * NT + tid; i < 8 * 128 * 128; i += G * NT) sgw[i] = f2bf(s[i]);
      cf* tw = (cf*)(p.ws + WS_TW);
      for (int i = bid * NT + tid; i < 2048; i += G * NT) { float sn, cs; sincospif(-2.0f * (float)i / (float)FFT_N, &sn, &cs); tw[i] = cf{cs, sn}; } }
    { bf16_t* hn = (bf16_t*)p.out; const float* x = p.in[0]; const float* w = p.in[1];
      for (int row = bid * 8 + wave; row < MTOK; row += G * 8) {
          const float* xr = x + (size_t)row * DM; float4 v[4]; float ss = 0.f;
#pragma unroll
          for (int i = 0; i < 4; ++i) { v[i] = *(const float4*)(xr + i * 256 + lane * 4); ss += v[i].x * v[i].x + v[i].y * v[i].y + v[i].z * v[i].z + v[i].w * v[i].w; }
          ss = wave_sum(ss);
          const float r = rsqrtf(ss * (1.0f / DM) + EPSF);
#pragma unroll
          for (int i = 0; i < 4; ++i) { const float4 ww = *(const float4*)(w + i * 256 + lane * 4);
              uint2 o; o.x = pk_bf16(v[i].x * r * ww.x, v[i].y * r * ww.y); o.y = pk_bf16(v[i].z * r * ww.z, v[i].w * r * ww.w);
              *(uint2*)(hn + (size_t)row * DM + i * 256 + lane * 4) = o; }
      } }
}

struct EpiHyT {
    static constexpr bool PERM = false, AFTER_DRAIN = false, SWAP = true;
    bf16_t* O;
    __device__ __forceinline__ void operator()(const pg8::f32x4 (&acc)[2][2][4][2], const pg8::Unit& u, int wr, int wc, int fr, int fq) const {
        const int row0 = u.pm * 256 + wr * 64 + 4 * fq, b = row0 >> 13, t0 = row0 & (SEQ - 1);
        const int ch0 = u.pn * 256 + wc * 32 + fr;
#pragma unroll
        for (int bj = 0; bj < 2; ++bj)
#pragma unroll
            for (int n = 0; n < 2; ++n) { bf16_t* cp = O + ((size_t)b * NHY + ch0 + bj * 128 + n * 16) * SEQ + t0;
#pragma unroll
                for (int ai = 0; ai < 2; ++ai)
#pragma unroll
                    for (int m = 0; m < 4; ++m) { const pg8::f32x4 v = acc[ai][bj][m][n]; uint2 o; o.x = pk_bf16(v[0], v[1]); o.y = pk_bf16(v[2], v[3]);
                        *(uint2*)(cp + ai * 128 + m * 16) = o; } }
    }
};

__device__ __forceinline__ void fft_fwd(cf* X, const cf* tw, int tid) {
    fft_stage<16, false, 1024, 1>(X, tw, tid, NT); __syncthreads();
    fft_stage<16, false, 64, 16>(X, tw, tid, NT); __syncthreads();
    fft_stage<8, false, 8, 256>(X, tw, tid, NT); __syncthreads();
    fft_stage<8, false, 1, 0>(X, tw, tid, NT); __syncthreads();
}
__device__ __forceinline__ void fft_inv(cf* X, const cf* tw, int tid) {
    fft_stage<8, true, 1, 0>(X, tw, tid, NT); __syncthreads();
    fft_stage<8, true, 8, 256>(X, tw, tid, NT); __syncthreads();
    fft_stage<16, true, 64, 16>(X, tw, tid, NT); __syncthreads();
    fft_stage<16, true, 1024, 1>(X, tw, tid, NT); __syncthreads();
}
__device__ __forceinline__ void conv8(const bf16_t* row, int t0, float w0, float w1, float w2, float bias, float (&o)[8]) {
    const uint4 q = *(const uint4*)(row + t0);
    float v[10];
    v[0] = t0 > 0 ? bf2f(row[t0 - 1]) : 0.f;
    v[1] = bf_lo(q.x); v[2] = bf_hi(q.x); v[3] = bf_lo(q.y); v[4] = bf_hi(q.y); v[5] = bf_lo(q.z); v[6] = bf_hi(q.z); v[7] = bf_lo(q.w); v[8] = bf_hi(q.w);
    v[9] = (t0 + 8 < SEQ) ? bf2f(row[t0 + 8]) : 0.f;
#pragma unroll
    for (int j = 0; j < 8; ++j) o[j] = v[j] * w0 + v[j + 1] * w1 + v[j + 2] * w2 + bias;
}
__device__ __forceinline__ void hyena_job(const Params& p, int c, unsigned char* lds) {
    cf* X = (cf*)lds; float* red = (float*)(lds + FFT_LDS_CF * 8);
    const int tid = threadIdx.x, lane = tid & 63, wave = tid >> 6;
    const cf* tw = (const cf*)(p.ws + WS_TW);
    bf16_t* HYT = (bf16_t*)(p.ws + WS_HYT);
    const float* cw = p.in[3]; const float* cb = p.in[4];
    { const float* kr = (const float*)((const unsigned char*)p.out + 64 * MiB) + (size_t)c * FFT_N;
      float l1 = 0.f;
      for (int i = tid * 4; i < FFT_N; i += NT * 4) { const float4 v = *(const float4*)(kr + i); l1 += fabsf(v.x) + fabsf(v.y) + fabsf(v.z) + fabsf(v.w);
          const int pi = PADI(i); X[pi] = cf{v.x, 0.f}; X[pi + 1] = cf{v.y, 0.f}; X[pi + 2] = cf{v.z, 0.f}; X[pi + 3] = cf{v.w, 0.f}; }
      l1 = wave_sum(l1); if (lane == 0) red[wave] = l1;
      __syncthreads();
      float tot = 0.f;
#pragma unroll
      for (int i = 0; i < 8; ++i) tot += red[i];
      fft_fwd(X, tw, tid);
      const float sc = 1.0f / ((tot + EPSF) * (float)FFT_N), sk = p.in[15][c] * (1.0f / (float)FFT_N);
      unsigned long long* ks = (unsigned long long*)(p.ws + WS_KSCR) + (size_t)blockIdx.x * FFT_N;
      for (int i = tid; i < FFT_N; i += NT) { const cf v = X[PADI(i)]; const float re = v.x * sc + sk, im = v.y * sc;
          __hip_atomic_store(ks + i, ((unsigned long long)__float_as_uint(im) << 32) | __float_as_uint(re), __ATOMIC_RELAXED, __HIP_MEMORY_SCOPE_AGENT); }
      __threadfence(); __syncthreads(); }
    const unsigned long long* ks = (const unsigned long long*)(p.ws + WS_KSCR) + (size_t)blockIdx.x * FFT_N;
    const float x0w0 = cw[c], x0w1 = cw[3072 + c], x0w2 = cw[6144 + c], x0b = cb[c];
    const float x1w0 = cw[1024 + c], x1w1 = cw[3072 + 1024 + c], x1w2 = cw[6144 + 1024 + c], x1b = cb[1024 + c];
    const float vw0 = cw[2048 + c], vw1 = cw[3072 + 2048 + c], vw2 = cw[6144 + 2048 + c], vb = cb[2048 + c];
#pragma unroll 1
    for (int pair = 0; pair < 2; ++pair) {
        const int b0 = 2 * pair, b1 = b0 + 1;
        const bf16_t* x1r0 = HYT + ((size_t)b0 * NHY + 1024 + c) * SEQ; const bf16_t* x1r1 = HYT + ((size_t)b1 * NHY + 1024 + c) * SEQ;
        bf16_t* vr0 = HYT + ((size_t)b0 * NHY + 2048 + c) * SEQ; bf16_t* vr1 = HYT + ((size_t)b1 * NHY + 2048 + c) * SEQ;
#pragma unroll 1
        for (int ch = tid; ch < SEQ / 8; ch += NT) {
            const int t0 = ch * 8; float a[8], b[8], u0[8], u1[8];
            conv8(vr0, t0, vw0, vw1, vw2, vb, a); conv8(x1r0, t0, x1w0, x1w1, x1w2, x1b, b);
#pragma unroll
            for (int j = 0; j < 8; ++j) u0[j] = a[j] * b[j];
            conv8(vr1, t0, vw0, vw1, vw2, vb, a); conv8(x1r1, t0, x1w0, x1w1, x1w2, x1b, b);
#pragma unroll
            for (int j = 0; j < 8; ++j) u1[j] = a[j] * b[j];
            const int pi = PADI(t0), pz = PADI(SEQ + t0);
#pragma unroll
            for (int j = 0; j < 8; ++j) { X[pi + j] = cf{u0[j], u1[j]}; X[pz + j] = cf{0.f, 0.f}; }
        }
        __syncthreads();
        fft_fwd(X, tw, tid);
        for (int i = tid; i < FFT_N; i += NT) { const unsigned long long kk = __hip_atomic_load(ks + i, __ATOMIC_RELAXED, __HIP_MEMORY_SCOPE_AGENT);
            const cf k = cf{__uint_as_float((unsigned)kk), __uint_as_float((unsigned)(kk >> 32))}; const int pi = PADI(i); X[pi] = cmul(X[pi], k); }
        __syncthreads();
        fft_inv(X, tw, tid);
        const bf16_t* x0r0 = HYT + ((size_t)b0 * NHY + c) * SEQ; const bf16_t* x0r1 = HYT + ((size_t)b1 * NHY + c) * SEQ;
        const bf16_t* gr0 = HYT + ((size_t)b0 * NHY + 3072 + c) * SEQ; const bf16_t* gr1 = HYT + ((size_t)b1 * NHY + 3072 + c) * SEQ;
#pragma unroll 1
        for (int ch = tid; ch < SEQ / 8; ch += NT) {
            const int t0 = ch * 8, pi = PADI(t0); float a[8], y[8];
            { conv8(x0r0, t0, x0w0, x0w1, x0w2, x0b, a); const uint4 g = *(const uint4*)(gr0 + t0);
              const float gg[8] = {bf_lo(g.x), bf_hi(g.x), bf_lo(g.y), bf_hi(g.y), bf_lo(g.z), bf_hi(g.z), bf_lo(g.w), bf_hi(g.w)};
#pragma unroll
              for (int j = 0; j < 8; ++j) y[j] = a[j] * X[pi + j].x * siluf(gg[j]);
              uint4 o; o.x = pk_bf16(y[0], y[1]); o.y = pk_bf16(y[2], y[3]); o.z = pk_bf16(y[4], y[5]); o.w = pk_bf16(y[6], y[7]);
              *(uint4*)(vr0 + t0) = o; }
            { conv8(x0r1, t0, x0w0, x0w1, x0w2, x0b, a); const uint4 g = *(const uint4*)(gr1 + t0);
              const float gg[8] = {bf_lo(g.x), bf_hi(g.x), bf_lo(g.y), bf_hi(g.y), bf_lo(g.z), bf_hi(g.z), bf_lo(g.w), bf_hi(g.w)};
#pragma unroll
              for (int j = 0; j < 8; ++j) y[j] = a[j] * X[pi + j].y * siluf(gg[j]);
              uint4 o; o.x = pk_bf16(y[0], y[1]); o.y = pk_bf16(y[2], y[3]); o.z = pk_bf16(y[4], y[5]); o.w = pk_bf16(y[6], y[7]);
              *(uint4*)(vr1 + t0) = o; }
        }
        __syncthreads();
    }
}

__device__ __forceinline__ void gmlp_job(const Params& p, int chunk, int h, unsigned char* lds) {
    constexpr int PITCH = 136;
    bf16_t* vnT = (bf16_t*)lds;
    bf16_t* SG = (bf16_t*)(p.ws + WS_SG);
    const bf16_t* sgw = (const bf16_t*)(p.ws + WS_SGW);
    const int tid = threadIdx.x, lane = tid & 63, wave = tid >> 6;
    const size_t t0 = (size_t)chunk * 128;
    {
        const int q = tid >> 2, part = tid & 3;
        const bf16_t* src = SG + (t0 + q) * NSG + 1024 + h * 128 + part * 32;
        float v[32];
#pragma unroll
        for (int j = 0; j < 4; ++j) { const uint4 w = *(const uint4*)(src + j * 8);
            v[8 * j + 0] = bf_lo(w.x); v[8 * j + 1] = bf_hi(w.x); v[8 * j + 2] = bf_lo(w.y); v[8 * j + 3] = bf_hi(w.y);
            v[8 * j + 4] = bf_lo(w.z); v[8 * j + 5] = bf_hi(w.z); v[8 * j + 6] = bf_lo(w.w); v[8 * j + 7] = bf_hi(w.w); }
        float s = 0.f;
#pragma unroll
        for (int j = 0; j < 32; ++j) s += v[j];
        s += __shfl_xor(s, 1); s += __shfl_xor(s, 2);
        const float mu = s * (1.0f / 128.0f);
        float qq = 0.f;
#pragma unroll
        for (int j = 0; j < 32; ++j) { const float d = v[j] - mu; qq += d * d; }
        qq += __shfl_xor(qq, 1); qq += __shfl_xor(qq, 2);
        const float rstd = rsqrtf(qq * (1.0f / 128.0f) + EPSF);
        const float* nw = p.in[16] + h * 128 + part * 32; const float* nb = p.in[17] + h * 128 + part * 32;
#pragma unroll
        for (int j = 0; j < 32; ++j) vnT[(part * 32 + j) * PITCH + q] = f2bf((v[j] - mu) * rstd * nw[j] + nb[j]);
    }
    __syncthreads();
    const int fr = lane & 15, fq = lane >> 4, p0 = wave * 16;
    bf16x8 wf[4];
#pragma unroll
    for (int ks = 0; ks < 4; ++ks) wf[ks] = *(const bf16x8*)(sgw + ((size_t)h * 128 + p0 + fr) * 128 + ks * 32 + fq * 8);
    const float bias = p.in[19][h * 128 + p0 + fr];
    const size_t trow = (t0 + p0 + fr) * NSG;
#pragma unroll
    for (int n = 0; n < 8; ++n) {
        f32x4 acc = (f32x4){0.f, 0.f, 0.f, 0.f};
#pragma unroll
        for (int ks = 0; ks < 4; ++ks) { const bf16x8 vf = *(const bf16x8*)(vnT + (16 * n + fr) * PITCH + ks * 32 + fq * 8);
            acc = __builtin_amdgcn_mfma_f32_16x16x32_bf16(vf, wf[ks], acc, 0, 0, 0); }
        const int d = h * 128 + 16 * n + 4 * fq;
        const uint2 uu = *(const uint2*)(SG + trow + d), gg = *(const uint2*)(SG + trow + 2048 + d);
        const float y0 = bf_lo(uu.x) * (acc[0] + bias) * siluf(bf_lo(gg.x)), y1 = bf_hi(uu.x) * (acc[1] + bias) * siluf(bf_hi(gg.x));
        const float y2 = bf_lo(uu.y) * (acc[2] + bias) * siluf(bf_lo(gg.y)), y3 = bf_hi(uu.y) * (acc[3] + bias) * siluf(bf_hi(gg.y));
        uint2 o; o.x = pk_bf16(y0, y1); o.y = pk_bf16(y2, y3);
        *(uint2*)(SG + trow + d) = o;
    }
    __syncthreads();
}

__device__ __forceinline__ void ya_transpose_tile(const Params& p, int tile, unsigned char* lds) {
    bf16_t* T = (bf16_t*)lds;
    const bf16_t* HYT = (const bf16_t*)(p.ws + WS_HYT); bf16_t* SG = (bf16_t*)(p.ws + WS_SG);
    const int tid = threadIdx.x;
    const int tt = tile & 127, ct = (tile >> 7) & 15, b = tile >> 11;
    { const int c = tid >> 3, tc = (tid & 7) * 8;
      const uint4 v = *(const uint4*)(HYT + ((size_t)b * NHY + 2048 + ct * 64 + c) * SEQ + tt * 64 + tc);
      T[(tc + 0) * 72 + c] = (bf16_t)(v.x & 0xffff); T[(tc + 1) * 72 + c] = (bf16_t)(v.x >> 16); T[(tc + 2) * 72 + c] = (bf16_t)(v.y & 0xffff); T[(tc + 3) * 72 + c] = (bf16_t)(v.y >> 16);
      T[(tc + 4) * 72 + c] = (bf16_t)(v.z & 0xffff); T[(tc + 5) * 72 + c] = (bf16_t)(v.z >> 16); T[(tc + 6) * 72 + c] = (bf16_t)(v.w & 0xffff); T[(tc + 7) * 72 + c] = (bf16_t)(v.w >> 16); }
    __syncthreads();
    { const int t = tid >> 3, cc = (tid & 7) * 8;
      const uint4 v = *(const uint4*)(T + t * 72 + cc);
      *(uint4*)(SG + ((size_t)b * SEQ + tt * 64 + t) * NSG + 1024 + ct * 64 + cc) = v; }
    __syncthreads();
}

__device__ __forceinline__ void phase5(const Params& p) {
    const int tid = threadIdx.x, lane = tid & 63, wave = tid >> 6, G = gridDim.x, bid = blockIdx.x;
    const float* x = p.in[0]; const float* w = p.in[21]; float* out = p.out;
    for (int row = bid * 8 + wave; row < MTOK; row += G * 8) {
        float* yr = out + (size_t)row * DM; const float* xr = x + (size_t)row * DM; float4 v[4]; float ss = 0.f;
#pragma unroll
        for (int i = 0; i < 4; ++i) { v[i] = *(const float4*)(yr + i * 256 + lane * 4); ss += v[i].x * v[i].x + v[i].y * v[i].y + v[i].z * v[i].z + v[i].w * v[i].w; }
        ss = wave_sum(ss);
        const float r = rsqrtf(ss * (1.0f / DM) + EPSF);
#pragma unroll
        for (int i = 0; i < 4; ++i) { const float4 ww = *(const float4*)(w + i * 256 + lane * 4), xx = *(const float4*)(xr + i * 256 + lane * 4);
            float4 o; o.x = xx.x + v[i].x * r * ww.x; o.y = xx.y + v[i].y * r * ww.y; o.z = xx.z + v[i].z * r * ww.z; o.w = xx.w + v[i].w * r * ww.w;
            *(float4*)(yr + i * 256 + lane * 4) = o; }
    }
}

__global__ void __launch_bounds__(NT, 2) hyena_gmlp_fwd(Params p) {
    extern __shared__ __attribute__((aligned(16))) unsigned char lds[];
    cg::grid_group grid = cg::this_grid();
    const int G = gridDim.x, bid = blockIdx.x;
    PG8_LAS unsigned char* ldsl = (PG8_LAS unsigned char*)lds;

#ifndef SKIP_P0
    phase0(p, lds);
#endif
    grid.sync();

#ifndef SKIP_P1A
    {
        pg8::Gemm g{(const bf16_t*)p.out, (const bf16_t*)(p.ws + WS_W1T), MTOK, NHY, DM, DM};
        pg8::StaticOrder S; S.init(MTOK, NHY, G, bid);
        EpiHyT E{(bf16_t*)(p.ws + WS_HYT)};
        pg8::gemm_phase<EpiHyT, pg8::StaticOrder>(ldsl, g, S, E, nullptr);
    }
#endif
#ifndef SKIP_P1B
    {
        pg8::Gemm g{(const bf16_t*)p.out, (const bf16_t*)(p.ws + WS_W1T) + (size_t)NHY * DM, MTOK, NSG, DM, DM};
        pg8::StaticOrder S; S.init(MTOK, NSG, G, bid);
        pg8::EpiBf16<0> E{(bf16_t*)(p.ws + WS_SG), NSG, nullptr, 0, 0};
        pg8::gemm_phase<pg8::EpiBf16<0>, pg8::StaticOrder>(ldsl, g, S, E, nullptr);
    }
#endif
    grid.sync();

#ifndef SKIP_P2A
    for (int c = bid; c < 1024; c += G) hyena_job(p, c, lds);
#endif
#ifndef SKIP_P2B
    for (int j = bid; j < 2048; j += G) gmlp_job(p, j >> 3, j & 7, lds);
#endif
    grid.sync();

#ifndef SKIP_P3
    for (int t = bid; t < 8192; t += G) ya_transpose_tile(p, t, lds);
#endif
    grid.sync();

#ifndef SKIP_P4
    {
        pg8::Gemm g{(const bf16_t*)(p.ws + WS_SG), (const bf16_t*)(p.ws + WS_W2T), MTOK, DM, 2048, NSG};
        pg8::StaticOrder S; S.init(MTOK, DM, G, bid);
        pg8::EpiF32 E{p.out, DM, nullptr};
        pg8::gemm_phase<pg8::EpiF32, pg8::StaticOrder>(ldsl, g, S, E, nullptr);
    }
#endif
    grid.sync();

#ifndef SKIP_P5
    phase5(p);
#endif
}

extern "C" void kernel_launch(void* const* d_in, const int* in_sizes, int n_in, void* d_out, int out_size, void* d_ws, size_t ws_size, hipStream_t stream) {
    static int grid_blocks = 0;
    if (grid_blocks == 0) {
        if (n_in != 22 || out_size != MTOK * DM || ws_size < WS_END) { fprintf(stderr, "kernel_launch: unexpected shapes (n_in %d out %d ws %zu need %zu)\n", n_in, out_size, ws_size, (size_t)WS_END); grid_blocks = -1; return; }
        int dev = 0, cus = 0, per_cu = 0;
        hipGetDevice(&dev);
        hipDeviceGetAttribute(&cus, hipDeviceAttributeMultiprocessorCount, dev);
        if (hipFuncSetAttribute((const void*)hyena_gmlp_fwd, hipFuncAttributeMaxDynamicSharedMemorySize, LDS_BYTES) != hipSuccess) { fprintf(stderr, "kernel_launch: hipFuncSetAttribute failed\n"); grid_blocks = -1; return; }
        if (hipOccupancyMaxActiveBlocksPerMultiprocessor(&per_cu, (const void*)hyena_gmlp_fwd, NT, LDS_BYTES) != hipSuccess || per_cu < 1) { fprintf(stderr, "kernel_launch: occupancy query says %d\n", per_cu); (void)hipGetLastError(); grid_blocks = -1; return; }
        grid_blocks = cus * per_cu;
        if (grid_blocks > 256) grid_blocks = 256;
    }
    if (grid_blocks < 0) return;
    Params p{};
    for (int i = 0; i < 22; ++i) p.in[i] = (const float*)d_in[i];
    p.out = (float*)d_out; p.ws = (unsigned char*)d_ws;
    void* args[] = {&p};
    hipError_t e = hipLaunchCooperativeKernel((const void*)hyena_gmlp_fwd, dim3(grid_blocks), dim3(NT), args, LDS_BYTES, stream);
    if (e != hipSuccess) fprintf(stderr, "cooperative launch failed: %s (grid %d)\n", hipGetErrorString(e), grid_blocks);
}
```

```cpp
#include <hip/hip_runtime.h>
#include <hip/hip_cooperative_groups.h>
#include <cstdio>
#include <cstdint>
namespace cg = cooperative_groups;

#define HD __host__ __device__ __forceinline__
typedef float cf __attribute__((ext_vector_type(2)));
constexpr int FFT_N = 16384;
constexpr int FFT_LDS_CF = FFT_N + (FFT_N >> 5) * 2 + (FFT_N >> 9) * 16;
HD int PADI(int i) { return i + ((i >> 5) << 1) + ((i >> 9) << 4); }
HD constexpr int PADOFF(int d) { return d + ((d >> 5) << 1) + ((d >> 9) << 4); }
HD cf cadd(cf a, cf b) { return a + b; }
HD cf csub(cf a, cf b) { return a - b; }
HD cf cmul(cf a, cf b) {
#if defined(__HIP_DEVICE_COMPILE__)
    cf t, r;
    asm("v_pk_mul_f32 %0, %1, %2 op_sel:[0,0] op_sel_hi:[0,1]" : "=v"(t) : "v"(a), "v"(b));
    asm("v_pk_fma_f32 %0, %1, %2, %3 op_sel:[1,1,0] op_sel_hi:[1,0,1] neg_lo:[0,1,0] neg_hi:[0,0,0]" : "=v"(r) : "v"(a), "v"(b), "v"(t));
    return r;
#else
    return cf{a.x * b.x - a.y * b.y, a.x * b.y + a.y * b.x};
#endif
}
template <bool INV> HD cf twc(cf a, float c, float s) { return INV ? __builtin_elementwise_fma(a.yx, cf{-s, s}, a * c) : __builtin_elementwise_fma(a.yx, cf{s, -s}, a * c); }
template <bool INV> HD cf mul_mi(cf a) { return INV ? cf{-a.y, a.x} : cf{a.y, -a.x}; }
template <bool INV> HD void dft4(cf& a0, cf& a1, cf& a2, cf& a3) {
    const cf t0 = cadd(a0, a2), t1 = csub(a0, a2), t2 = cadd(a1, a3), t3 = mul_mi<INV>(csub(a1, a3));
    a0 = cadd(t0, t2); a2 = csub(t0, t2); a1 = cadd(t1, t3); a3 = csub(t1, t3);
}
template <int R> HD constexpr int KIDX(int j) { return R == 32 ? ((j >> 3) + 4 * (((j & 7) >> 1) + 4 * (j & 1))) : R == 16 ? ((j >> 2) + 4 * (j & 3)) : ((j >> 1) + 4 * (j & 1)); }
template <int R> HD constexpr int JIDX(int k) { return R == 32 ? (8 * (k & 3) + 2 * ((k >> 2) & 3) + (k >> 4)) : R == 16 ? ((k >> 2) + 4 * (k & 3)) : (2 * (k & 3) + (k >> 2)); }
template <bool INV> HD void dft8r(cf& a0, cf& a1, cf& a2, cf& a3, cf& a4, cf& a5, cf& a6, cf& a7) {
    dft4<INV>(a0, a2, a4, a6);
    dft4<INV>(a1, a3, a5, a7);
    const float c = 0.70710678118654752f;
    a3 = twc<INV>(a3, c, c);
    a5 = mul_mi<INV>(a5);
    a7 = twc<INV>(a7, -c, c);
    { const cf e = a0, o = a1; a0 = cadd(e, o); a1 = csub(e, o); }
    { const cf e = a2, o = a3; a2 = cadd(e, o); a3 = csub(e, o); }
    { const cf e = a4, o = a5; a4 = cadd(e, o); a5 = csub(e, o); }
    { const cf e = a6, o = a7; a6 = cadd(e, o); a7 = csub(e, o); }
}
template <bool INV> HD void dft8(cf (&a)[8]) { dft8r<INV>(a[0], a[1], a[2], a[3], a[4], a[5], a[6], a[7]); }
template <bool INV> HD void dft8h(cf& a0, cf& a1, cf& a2, cf& a3, cf& a4, cf& a5, cf& a6, cf& a7) {
    dft4<INV>(a0, a2, a4, a6);
    dft4<INV>(a1, a3, a5, a7);
    const float c = 0.70710678118654752f;
    a3 = twc<INV>(a3, c, c);
    a5 = mul_mi<INV>(a5);
    a7 = twc<INV>(a7, -c, c);
    a0 = cadd(a0, a1); a2 = cadd(a2, a3); a4 = cadd(a4, a5); a6 = cadd(a6, a7);
}
template <bool INV> HD void dft16(cf (&a)[16]) {
#pragma unroll
    for (int s = 0; s < 4; ++s) dft4<INV>(a[s], a[s + 4], a[s + 8], a[s + 12]);
    const float c1 = 0.92387953251128674f, s1 = 0.38268343236508977f, c2 = 0.70710678118654752f;
    a[1 + 4] = twc<INV>(a[1 + 4], c1, s1);
    a[2 + 4] = twc<INV>(a[2 + 4], c2, c2);
    a[3 + 4] = twc<INV>(a[3 + 4], s1, c1);
    a[1 + 8] = twc<INV>(a[1 + 8], c2, c2);
    a[2 + 8] = mul_mi<INV>(a[2 + 8]);
    a[3 + 8] = twc<INV>(a[3 + 8], -c2, c2);
    a[1 + 12] = twc<INV>(a[1 + 12], s1, c1);
    a[2 + 12] = twc<INV>(a[2 + 12], -c2, c2);
    a[3 + 12] = twc<INV>(a[3 + 12], -c1, -s1);
#pragma unroll
    for (int k1 = 0; k1 < 4; ++k1) dft4<INV>(a[4 * k1], a[4 * k1 + 1], a[4 * k1 + 2], a[4 * k1 + 3]);
}
template <bool INV, int MODE> HD void dft32m(cf (&a)[32]) {
    constexpr float C32[22] = {1.000000000e+00f, 9.807852804e-01f, 9.238795325e-01f, 8.314696123e-01f, 7.071067812e-01f, 5.555702330e-01f, 3.826834324e-01f, 1.950903220e-01f, 0.000000000e+00f, -1.950903220e-01f, -3.826834324e-01f, -5.555702330e-01f, -7.071067812e-01f, -8.314696123e-01f, -9.238795325e-01f, -9.807852804e-01f, -1.000000000e+00f, -9.807852804e-01f, -9.238795325e-01f, -8.314696123e-01f, -7.071067812e-01f, -5.555702330e-01f};
    constexpr float S32[22] = {0.000000000e+00f, 1.950903220e-01f, 3.826834324e-01f, 5.555702330e-01f, 7.071067812e-01f, 8.314696123e-01f, 9.238795325e-01f, 9.807852804e-01f, 1.000000000e+00f, 9.807852804e-01f, 9.238795325e-01f, 8.314696123e-01f, 7.071067812e-01f, 5.555702330e-01f, 3.826834324e-01f, 1.950903220e-01f, 0.000000000e+00f, -1.950903220e-01f, -3.826834324e-01f, -5.555702330e-01f, -7.071067812e-01f, -8.314696123e-01f};
    if constexpr (MODE == 1) {
#pragma unroll
        for (int s = 0; s < 8; ++s) { const cf t0 = a[s], t3 = mul_mi<INV>(a[s + 8]); const cf t2 = a[s + 8];
            a[s] = cadd(t0, t2); a[s + 16] = csub(t0, t2); a[s + 8] = cadd(t0, t3); a[s + 24] = csub(t0, t3); }
    } else {
#pragma unroll
        for (int s = 0; s < 8; ++s) dft4<INV>(a[s], a[s + 8], a[s + 16], a[s + 24]);
    }
#pragma unroll
    for (int k1 = 1; k1 < 4; ++k1)
#pragma unroll
        for (int s = 1; s < 8; ++s) { const int e = s * k1;
            if (e == 8) a[s + 8 * k1] = mul_mi<INV>(a[s + 8 * k1]); else a[s + 8 * k1] = twc<INV>(a[s + 8 * k1], C32[e], S32[e]); }
#pragma unroll
    for (int k1 = 0; k1 < 4; ++k1) {
        if constexpr (MODE == 2) dft8h<INV>(a[8 * k1], a[8 * k1 + 1], a[8 * k1 + 2], a[8 * k1 + 3], a[8 * k1 + 4], a[8 * k1 + 5], a[8 * k1 + 6], a[8 * k1 + 7]);
        else dft8r<INV>(a[8 * k1], a[8 * k1 + 1], a[8 * k1 + 2], a[8 * k1 + 3], a[8 * k1 + 4], a[8 * k1 + 5], a[8 * k1 + 6], a[8 * k1 + 7]);
    }
}
template <bool INV> HD void dft32(cf (&a)[32]) { dft32m<INV, 0>(a); }
template <int R, bool INV> HD void dftR(cf (&a)[R]) { if constexpr (R == 32) dft32<INV>(a); else if constexpr (R == 16) dft16<INV>(a); else dft8<INV>(a); }
template <int R, bool INV, int S, int TWS, int MODE = 0, class XP, class TP>
HD void fft_stage(XP X, TP tw, int tid, int nthreads) {
    constexpr int NB = FFT_N / R;
#pragma unroll 2
    for (int g = tid; g < NB; g += nthreads) {
        const int np = g & (S - 1);
        const int base = (g - np) * R + np;
        const int pb = PADI(base);
        cf a[R];
#pragma unroll
        for (int j = 0; j < R; ++j) { if (MODE == 1 && j >= R / 2) a[j] = cf{0.f, 0.f}; else a[j] = X[pb + PADOFF(j * S)]; }
        cf w = cf{1.f, 0.f};
        if constexpr (TWS != 0) { w = tw[np * TWS]; if (INV) w.y = -w.y; }
        if constexpr (INV && TWS != 0) {
            cf p = w;
#pragma unroll
            for (int j = 1; j < R; ++j) { a[j] = cmul(a[j], p); p = cmul(p, w); }
        }
        if constexpr (R == 32 && MODE != 0) dft32m<INV, MODE>(a); else dftR<R, INV>(a);
        if constexpr (!INV && TWS != 0) {
            cf p = w;
#pragma unroll
            for (int k = 1; k < R; ++k) { a[JIDX<R>(k)] = cmul(a[JIDX<R>(k)], p); p = cmul(p, w); }
        }
#pragma unroll
        for (int j = 0; j < R; ++j) { if (MODE == 2 && KIDX<R>(j) >= R / 2) continue; X[pb + PADOFF(KIDX<R>(j) * S)] = a[j]; }
    }
}
namespace pg8 {
#define PG8_LAS __attribute__((address_space(3)))
typedef unsigned short bf16_t;
typedef short bf16x8 __attribute__((ext_vector_type(8)));
typedef float f32x4 __attribute__((ext_vector_type(4)));
typedef unsigned u32x4 __attribute__((ext_vector_type(4)));
constexpr int BM = 256, BK = 64, HALF = 128, HTB = HALF * BK * 2  , STAGE_BYTES = 8 * HTB, NXCD = 8, WGM = 8;

__host__ __device__ __forceinline__ int lds_byte(int r, int c) { const int st = (r >> 4) * 2 + (c >> 5), rr = r & 15, cc = c & 31, ob = rr * 64 + cc * 2; return st * 1024 + (ob ^ (((ob >> 9) & 1) << 5)); }
__host__ __device__ __forceinline__ void stage_rc(int b, int& R, int& C) { const int st = b / 1024, sb = b % 1024, swz = sb ^ (((sb >> 9) & 1) << 5); R = (st >> 1) * 16 + swz / 64; C = (st & 1) * 32 + (swz % 64) / 2; }
__host__ __device__ __forceinline__ int perm32(int rho) { const int n = rho >> 4, i = rho & 15; return 8 * (i >> 2) + 4 * n + (i & 3); }

struct Unit { int pm, pn; };
struct Gemm { const bf16_t* A; const bf16_t* Bt; int M, N, K, lda; };

struct StaticOrder {
    int nM, nN, nwg, G, c;
    __host__ __device__ void init(int M, int N, int G_, int c_) { nM = M / BM; nN = N / BM; nwg = nM * nN; G = G_; c = c_; }
    __host__ __device__ bool next(int i, Unit& u) const {
        const long L = (long)i * G + c; if (L >= nwg) return false;
        int wgid = (int)L; { const int q = nwg / NXCD, r = nwg % NXCD, xcd = wgid % NXCD, off = wgid / NXCD; wgid = (xcd < r ? xcd * (q + 1) : r * (q + 1) + (xcd - r) * q) + off; }
        const int nig = WGM * nN, gid = wgid / nig, fm = gid * WGM, gsz = (nM - fm) < WGM ? (nM - fm) : WGM;
        u.pm = fm + ((wgid % nig) % gsz); u.pn = (wgid % nig) / gsz; return true;
    }
    __device__ __forceinline__ void a_ready(const Unit&) const {}
    __device__ __forceinline__ void done(const Unit&) const {}
};
__device__ __forceinline__ unsigned cvt_pk_bf16(float lo, float hi) { unsigned r; asm volatile("v_cvt_pk_bf16_f32 %0, %1, %2" : "=v"(r) : "v"(lo), "v"(hi)); return r; }
typedef float f32x2 __attribute__((ext_vector_type(2)));
__device__ __forceinline__ f32x2 gelu_pk(f32x2 v) {
    const f32x2 av = __builtin_elementwise_abs(v), d = av * 0.2316418882f + 1.0f;
    f32x2 t; t.x = __builtin_amdgcn_rcpf(d.x); t.y = __builtin_amdgcn_rcpf(d.y);
    f32x2 q = t * 0.5307027145f + (-0.7265760135f); q = q * t + 0.7107068705f; q = q * t + (-0.142248368f); q = q * t + 0.127414796f; q = q * t;
    const f32x2 s = (v * v) * (-0.72134752044f);
    f32x2 e; e.x = __builtin_amdgcn_exp2f(s.x); e.y = __builtin_amdgcn_exp2f(s.y);
    const f32x2 m = v * (q * e), r = v - m;
    f32x2 o; o.x = v.x < 0.f ? m.x : r.x; o.y = v.y < 0.f ? m.y : r.y; return o;
}

struct EpiF32 {
    static constexpr bool PERM = false, AFTER_DRAIN = false, SWAP = false;
    float* C; int ldc; const float* bias;
    __device__ __forceinline__ void operator()(const f32x4 (&acc)[2][2][4][2], const Unit& u, int wr, int wc, int fr, int fq) const {
        const int row0 = u.pm * BM + wr * 64 + fr, col0 = u.pn * BM + wc * 32 + 4 * fq;
        f32x4 bv[2][2];
#pragma unroll
        for (int bj = 0; bj < 2; ++bj)
#pragma unroll
            for (int n = 0; n < 2; ++n) bv[bj][n] = bias ? *(const f32x4*)(bias + col0 + bj * HALF + n * 16) : (f32x4){0.f, 0.f, 0.f, 0.f};
#pragma unroll
        for (int ai = 0; ai < 2; ++ai)
#pragma unroll
            for (int m = 0; m < 4; ++m) { float* rowp = C + (size_t)(row0 + ai * HALF + m * 16) * ldc + col0;
#pragma unroll
                for (int bj = 0; bj < 2; ++bj)
#pragma unroll
                    for (int n = 0; n < 2; ++n) *(f32x4*)(rowp + bj * HALF + n * 16) = acc[ai][bj][m][n] + bv[bj][n]; }
    }
};
template <int ACT  > struct EpiBf16 {
    static constexpr bool PERM = true, AFTER_DRAIN = false, SWAP = false;
    bf16_t* O; int ldc; const float* bias; int split_cols; size_t split_stride;
    __device__ __forceinline__ void operator()(const f32x4 (&acc)[2][2][4][2], const Unit& u, int wr, int wc, int fr, int fq) const {
        const int row0 = u.pm * BM + wr * 64 + fr; int colt = u.pn * BM; bf16_t* base = O;
        if (split_cols) { const int t = colt / split_cols; base += (size_t)t * split_stride; colt -= t * split_cols; }
        const int col0 = colt + wc * 32 + 8 * fq, bcol0 = u.pn * BM + wc * 32 + 8 * fq;
        f32x4 bv[2][2];
#pragma unroll
        for (int bj = 0; bj < 2; ++bj)
#pragma unroll
            for (int n = 0; n < 2; ++n) bv[bj][n] = bias ? *(const f32x4*)(bias + bcol0 + bj * HALF + 4 * n) : (f32x4){0.f, 0.f, 0.f, 0.f};
#pragma unroll
        for (int ai = 0; ai < 2; ++ai)
#pragma unroll
            for (int m = 0; m < 4; ++m) { bf16_t* rowp = base + (size_t)(row0 + ai * HALF + m * 16) * ldc + col0;
#pragma unroll
                for (int bj = 0; bj < 2; ++bj) { f32x4 v0 = acc[ai][bj][m][0] + bv[bj][0], v1 = acc[ai][bj][m][1] + bv[bj][1];
                    if (ACT == 1) { f32x2 a = gelu_pk((f32x2){v0[0], v0[1]}), b = gelu_pk((f32x2){v0[2], v0[3]}), c = gelu_pk((f32x2){v1[0], v1[1]}), d = gelu_pk((f32x2){v1[2], v1[3]});
                        v0 = (f32x4){a.x, a.y, b.x, b.y}; v1 = (f32x4){c.x, c.y, d.x, d.y}; }
                    if (ACT == 2) {
#pragma unroll
                        for (int j = 0; j < 4; ++j) { v0[j] = 0.5f * v0[j] * (1.0f + erff(v0[j] * 0.70710678f)); v1[j] = 0.5f * v1[j] * (1.0f + erff(v1[j] * 0.70710678f)); } }
                    u32x4 w; w.x = cvt_pk_bf16(v0[0], v0[1]); w.y = cvt_pk_bf16(v0[2], v0[3]); w.z = cvt_pk_bf16(v1[0], v1[1]); w.w = cvt_pk_bf16(v1[2], v1[3]);
                    *(u32x4*)(rowp + bj * HALF) = w; } }
    }
};
template <class Epi, class Sched, bool ALIGN_EPI = false, bool SP2 = false>
__device__ __forceinline__ void gemm_phase(PG8_LAS unsigned char* lds, const Gemm g, const Sched& S, const Epi& E) {
    const int tid = threadIdx.x, wid = __builtin_amdgcn_readfirstlane(tid >> 6), lane = tid & 63, wr = wid >> 2, wc = wid & 3, fr = lane & 15, fq = lane >> 4;
    const int K = g.K, nt = K / BK;
    unsigned voffA[2], voffB[2];
#pragma unroll
    for (int i = 0; i < 2; ++i) { int R, C; stage_rc(tid * 16 + i * 8192, R, C); const int Rb = Epi::PERM ? ((R & ~31) + perm32(R & 31)) : R;
        voffA[i] = (unsigned)(R * g.lda + C) * 2u; voffB[i] = (unsigned)(Rb * K + C) * 2u; }
    const size_t kstep = (size_t)(BK * 2);
    const size_t hstepA = (size_t)HALF * g.lda * 2, hstepB = (size_t)HALF * K * 2;
    const size_t tstepA = 2 * hstepA, tstepB = 2 * hstepB;
    const unsigned ldsw = (unsigned)wid * 1024u;
    const int aoff = lds_byte(wr * 64 + fr, fq * 8), boff = lds_byte(wc * 32 + fr, fq * 8);
#define PG8_SA(b, h) (((b) * 2 + (h)) * HTB)
#define PG8_SB(b, h) ((4 + (b) * 2 + (h)) * HTB)
#define PG8_STAGE(bufoff, gbase, voff) do { _Pragma("unroll") for (int _i = 0; _i < 2; ++_i) \
        __builtin_amdgcn_global_load_lds((const unsigned*)((const char*)(gbase) + (voff)[_i]), (PG8_LAS unsigned*)(lds + (bufoff) + ldsw + _i * 8192), 16, 0, 0); } while (0)
#define PG8_LDA(dst, b, h) do { _Pragma("unroll") for (int m = 0; m < 4; ++m) _Pragma("unroll") for (int k = 0; k < 2; ++k) dst[m][k] = *(const PG8_LAS bf16x8*)(lds + PG8_SA(b, h) + aoff + m * 2048 + k * 1024); } while (0)
#define PG8_LDB(dst, b, h) do { _Pragma("unroll") for (int n = 0; n < 2; ++n) _Pragma("unroll") for (int k = 0; k < 2; ++k) dst[n][k] = *(const PG8_LAS bf16x8*)(lds + PG8_SB(b, h) + boff + n * 2048 + k * 1024); } while (0)
#define PG8_MMA(ai, bj, At, Bt) do { __builtin_amdgcn_s_setprio(1); _Pragma("unroll") for (int m = 0; m < 4; ++m) _Pragma("unroll") for (int n = 0; n < 2; ++n) _Pragma("unroll") for (int k = 0; k < 2; ++k) \
        acc[ai][bj][m][n] = Epi::SWAP ? __builtin_amdgcn_mfma_f32_16x16x32_bf16(At[m][k], Bt[n][k], acc[ai][bj][m][n], 0, 0, 0) : __builtin_amdgcn_mfma_f32_16x16x32_bf16(Bt[n][k], At[m][k], acc[ai][bj][m][n], 0, 0, 0); __builtin_amdgcn_s_setprio(0); } while (0)
#define PG8_WAIT_V(n) asm volatile("s_waitcnt vmcnt(" #n ")" ::: "memory")
#define PG8_WAIT_L(n) asm volatile("s_waitcnt lgkmcnt(" #n ")" ::: "memory")
#define PG8_BAR __builtin_amdgcn_s_barrier()
#define PG8_SCHED __builtin_amdgcn_sched_barrier(0)
    Unit cur, nxt; int ui = 0;
    if (!S.next(0, cur)) return;
    f32x4 acc[2][2][4][2];
#pragma unroll
    for (int a = 0; a < 2; ++a)
#pragma unroll
        for (int b = 0; b < 2; ++b)
#pragma unroll
            for (int m = 0; m < 4; ++m)
#pragma unroll
                for (int n = 0; n < 2; ++n) acc[a][b][m][n] = (f32x4){0.f, 0.f, 0.f, 0.f};
    bf16x8 At[4][2], B0[2][2], B1[2][2];
    const char* cA = (const char*)g.A + (size_t)cur.pm * tstepA; const char* cB = (const char*)g.Bt + (size_t)cur.pn * tstepB;
    S.a_ready(cur);
    if constexpr (SP2) {
        PG8_STAGE(PG8_SB(0, 0), cB, voffB); PG8_STAGE(PG8_SB(0, 1), cB + hstepB, voffB); PG8_STAGE(PG8_SA(0, 0), cA, voffA); PG8_STAGE(PG8_SA(0, 1), cA + hstepA, voffA);
        if (wr == 1) PG8_BAR;
        PG8_WAIT_V(2); PG8_BAR;
        PG8_STAGE(PG8_SB(1, 0), cB + kstep, voffB); PG8_STAGE(PG8_SA(1, 0), cA + kstep, voffA); PG8_STAGE(PG8_SB(1, 1), cB + hstepB + kstep, voffB);
        PG8_WAIT_V(6); PG8_BAR;
    } else {
        PG8_STAGE(PG8_SB(0, 0), cB, voffB); PG8_STAGE(PG8_SA(0, 0), cA, voffA); PG8_STAGE(PG8_SB(0, 1), cB + hstepB, voffB); PG8_STAGE(PG8_SA(0, 1), cA + hstepA, voffA);
        if (wr == 1) PG8_BAR;
        PG8_WAIT_V(4); PG8_BAR;
        PG8_STAGE(PG8_SB(1, 0), cB + kstep, voffB); PG8_STAGE(PG8_SA(1, 0), cA + kstep, voffA); PG8_STAGE(PG8_SB(1, 1), cB + hstepB + kstep, voffB);
        PG8_WAIT_V(6); PG8_BAR;
    }
    for (;;) {
        const bool has_next = S.next(ui + 1, nxt);
        const char* nA = has_next ? (const char*)g.A + (size_t)nxt.pm * tstepA : cA; const char* nB = has_next ? (const char*)g.Bt + (size_t)nxt.pn * tstepB : cB;
        for (int t = 0; t < nt; t += 2) {
            const bool last = (t == nt - 2);
            const char* a1 = cA + (size_t)(t + 1) * kstep;
            const char* a2 = last ? nA : cA + (size_t)(t + 2) * kstep; const char* b2 = last ? nB : cB + (size_t)(t + 2) * kstep;
            const char* a3 = a2 + kstep; const char* b3 = b2 + kstep;
            if (last && has_next) S.a_ready(nxt);
            if constexpr (SP2) {
            PG8_LDB(B0, 0, 0); PG8_LDB(B1, 0, 1); PG8_SCHED; PG8_LDA(At, 0, 0); PG8_STAGE(PG8_SA(1, 1), a1 + hstepA, voffA);
            PG8_WAIT_V(8); PG8_WAIT_L(0); PG8_BAR; PG8_MMA(0, 0, At, B0); PG8_MMA(0, 1, At, B1); PG8_BAR; PG8_SCHED;
            PG8_LDA(At, 0, 1); PG8_STAGE(PG8_SB(0, 0), b2, voffB); PG8_STAGE(PG8_SB(0, 1), b2 + hstepB, voffB); PG8_STAGE(PG8_SA(0, 0), a2, voffA);
            PG8_WAIT_V(8); PG8_WAIT_L(0); PG8_BAR; PG8_MMA(1, 0, At, B0); PG8_MMA(1, 1, At, B1); PG8_BAR; PG8_SCHED;
            PG8_LDB(B0, 1, 0); PG8_LDB(B1, 1, 1); PG8_SCHED; PG8_LDA(At, 1, 0); PG8_STAGE(PG8_SA(0, 1), a2 + hstepA, voffA);
            PG8_WAIT_V(8); PG8_WAIT_L(0); PG8_BAR; PG8_MMA(0, 0, At, B0); PG8_MMA(0, 1, At, B1); PG8_BAR; PG8_SCHED;
            PG8_LDA(At, 1, 1); PG8_STAGE(PG8_SB(1, 0), b3, voffB); PG8_STAGE(PG8_SB(1, 1), b3 + hstepB, voffB); PG8_STAGE(PG8_SA(1, 0), a3, voffA);
            PG8_WAIT_V(8); PG8_WAIT_L(0); PG8_BAR; PG8_MMA(1, 0, At, B0); PG8_MMA(1, 1, At, B1); PG8_BAR; PG8_SCHED;
            } else {
            PG8_LDB(B0, 0, 0); PG8_SCHED; PG8_LDA(At, 0, 0); PG8_STAGE(PG8_SA(1, 1), a1 + hstepA, voffA);
            PG8_WAIT_L(8); PG8_BAR; PG8_WAIT_L(0); PG8_MMA(0, 0, At, B0); PG8_BAR; PG8_SCHED;
            PG8_LDB(B1, 0, 1); PG8_STAGE(PG8_SB(0, 0), b2, voffB);
            PG8_BAR; PG8_WAIT_L(0); PG8_MMA(0, 1, At, B1); PG8_BAR;
            PG8_LDA(At, 0, 1); PG8_STAGE(PG8_SA(0, 0), a2, voffA);
            PG8_BAR; PG8_WAIT_L(0); PG8_MMA(1, 0, At, B0); PG8_BAR; PG8_SCHED;
            PG8_STAGE(PG8_SB(0, 1), b2 + hstepB, voffB);
            PG8_WAIT_V(6); PG8_BAR; PG8_MMA(1, 1, At, B1); PG8_BAR;
            PG8_LDB(B0, 1, 0); PG8_SCHED; PG8_LDA(At, 1, 0); PG8_STAGE(PG8_SA(0, 1), a2 + hstepA, voffA);
            PG8_WAIT_L(8); PG8_BAR; PG8_WAIT_L(0); PG8_MMA(0, 0, At, B0); PG8_BAR; PG8_SCHED;
            PG8_LDB(B1, 1, 1); PG8_STAGE(PG8_SB(1, 0), b3, voffB);
            PG8_BAR; PG8_WAIT_L(0); PG8_MMA(0, 1, At, B1); PG8_BAR;
            PG8_LDA(At, 1, 1); PG8_STAGE(PG8_SA(1, 0), a3, voffA);
            PG8_BAR; PG8_WAIT_L(0); PG8_MMA(1, 0, At, B0); PG8_BAR; PG8_SCHED;
            PG8_STAGE(PG8_SB(1, 1), b3 + hstepB, voffB);
            PG8_WAIT_V(6); PG8_BAR; PG8_MMA(1, 1, At, B1); PG8_BAR;
            }
        }
        if constexpr (ALIGN_EPI) { if (wr == 0) PG8_BAR; }
        if constexpr (!Epi::AFTER_DRAIN) { E(acc, cur, wr, wc, fr, fq); S.done(cur); }
        if (!has_next) break;
#pragma unroll
        for (int a = 0; a < 2; ++a)
#pragma unroll
            for (int b = 0; b < 2; ++b)
#pragma unroll
                for (int m = 0; m < 4; ++m)
#pragma unroll
                    for (int n = 0; n < 2; ++n) acc[a][b][m][n] = (f32x4){0.f, 0.f, 0.f, 0.f};
        cur = nxt; cA = nA; cB = nB; ++ui;
        if constexpr (ALIGN_EPI) { if (wr == 1) PG8_BAR; }
    }
    PG8_WAIT_V(0);
    if constexpr (!ALIGN_EPI) { if (wr == 0) PG8_BAR; }
    PG8_BAR;
    if constexpr (Epi::AFTER_DRAIN) { E.fused(acc, cur, wr, wc, fr, fq, lds, wid, lane); S.done(cur); }
#undef PG8_SA
#undef PG8_SB
#undef PG8_STAGE
#undef PG8_LDA
#undef PG8_LDB
#undef PG8_MMA
#undef PG8_WAIT_V
#undef PG8_WAIT_L
#undef PG8_BAR
#undef PG8_SCHED
}
}

#ifndef PROBE_REP
#define PROBE_REP 0
#endif
#define NREP(k) ((PROBE_REP == (k)) ? 2 : 1)
constexpr int NT = 512;
#ifndef GEMM_SP2
#define GEMM_SP2 true
#endif
#ifndef GEMM_ALIGN
#define GEMM_ALIGN true
#endif
constexpr int BATCH = 4, SEQ = 8192, DM = 1024, MTOK = BATCH * SEQ, DIN = 7168, NHY = 4096, NSG = 3072;
constexpr float EPSF = 1e-6f;
constexpr size_t MiB = 1024ull * 1024ull;
constexpr size_t WS_W1T = 0;
constexpr size_t WS_W2T = WS_W1T + 14 * MiB;
constexpr size_t WS_TW = WS_W2T + 4 * MiB;
constexpr size_t WS_BAR = WS_TW + 16 * 1024;
constexpr size_t WS_SGW = WS_TW + 64 * 1024;
constexpr size_t WS_KSCR = WS_W2T + 5 * MiB;
constexpr size_t WS_HYT = WS_KSCR + 32 * MiB;
constexpr size_t WS_SG = WS_HYT + 256 * MiB;
constexpr size_t WS_END = WS_SG + 192 * MiB;
constexpr int LDS_ST_OFF = FFT_LDS_CF * 8 + 1024 + 2048 * 8;
constexpr int LDS_BYTES = LDS_ST_OFF + 16;

typedef unsigned short bf16_t;
typedef short bf16x8 __attribute__((ext_vector_type(8)));
typedef float f32x4 __attribute__((ext_vector_type(4)));

struct Params {
    const float* in[22];
    float* out;
    unsigned char* ws;
};

__device__ __forceinline__ unsigned pk_bf16(float lo, float hi) { unsigned r; asm volatile("v_cvt_pk_bf16_f32 %0, %1, %2" : "=v"(r) : "v"(lo), "v"(hi)); return r; }
__device__ __forceinline__ bf16_t f2bf(float f) { return (bf16_t)(pk_bf16(f, 0.f) & 0xffffu); }
__device__ __forceinline__ float bf_lo(unsigned u) { return __uint_as_float(u << 16); }
__device__ __forceinline__ float bf_hi(unsigned u) { return __uint_as_float(u & 0xffff0000u); }
__device__ __forceinline__ float bf2f(bf16_t b) { return __uint_as_float(((unsigned)b) << 16); }
__device__ __forceinline__ float siluf(float x) { return x * __builtin_amdgcn_rcpf(1.0f + __expf(-x)); }
__device__ __forceinline__ float wave_sum(float v) {
#pragma unroll
    for (int o = 32; o >= 1; o >>= 1) v += __shfl_xor(v, o);
    return v;
}

#define XB_TMO      128
#define XB_XCNT(j)  (256  + 64 * (j))
#define XB_XSUB(j)  (1280 + 64 * (j))
#define XB_XGEN(j)  (2304 + 64 * (j))
#define XB_TOP      3328
#define XB_TOPGEN   3392
#define XCD_BAR_WORDS 3456
#define XB_SPIN_CAP (1u << 18)
#define XB_LAS __attribute__((address_space(3)))

__device__ __forceinline__ unsigned xb_ld(unsigned* p)              { return __hip_atomic_load(p, __ATOMIC_RELAXED, __HIP_MEMORY_SCOPE_AGENT); }
__device__ __forceinline__ unsigned xb_add(unsigned* p, unsigned v) { return __hip_atomic_fetch_add(p, v, __ATOMIC_RELAXED, __HIP_MEMORY_SCOPE_AGENT); }
__device__ __forceinline__ unsigned xb_xcc_id() { return (unsigned)__builtin_amdgcn_s_getreg((3 << 11) | 20) & 0xFu; }
#define XB_SPIN(cond, bar) do { unsigned _sp = 0; while (cond) { __builtin_amdgcn_s_sleep(1); \
    if ((++_sp & 255u) == 0u) { if (xb_ld(&(bar)[XB_TMO])) break; if (_sp > XB_SPIN_CAP) { atomicAdd(&(bar)[XB_TMO], 1u); break; } } } } while (0)

struct XcdBarrier {
    unsigned* bar; unsigned x;
    volatile XB_LAS unsigned* st;
};

__device__ __forceinline__ XcdBarrier xcd_barrier_post(unsigned* bar, volatile XB_LAS unsigned* st) {
    XcdBarrier b; b.bar = bar; b.x = xb_xcc_id(); b.st = st;
    if (threadIdx.x == 0) (void)xb_add(&bar[XB_XCNT(b.x)], 1u);
    return b;
}
__device__ __forceinline__ void xcd_barrier_complete(unsigned* bar, unsigned x, unsigned& nloc, unsigned& nx) {
    const unsigned G = gridDim.x * gridDim.y * gridDim.z;
    unsigned sum, cnt, mine, sp = 0u;
    for (;;) {
        sum = 0u; cnt = 0u; mine = 0u;
#pragma unroll
        for (unsigned j = 0; j < 16; ++j) { const unsigned c = xb_ld(&bar[XB_XCNT(j)]); sum += c; cnt += (c > 0u) ? 1u : 0u; mine = (j == x) ? c : mine; }
        if (sum == G) break;
        __builtin_amdgcn_s_sleep(1);
        if ((++sp & 255u) == 0u) { if (xb_ld(&bar[XB_TMO])) break; if (sp > XB_SPIN_CAP) { atomicAdd(&bar[XB_TMO], 1u); break; } }
    }
    nloc = mine > 0u ? mine : 1u; nx = cnt > 0u ? cnt : 1u;
}

__device__ __forceinline__ void xcd_barrier(const XcdBarrier& b) {
    asm volatile("s_waitcnt vmcnt(0)" ::: "memory");
    __syncthreads();
    if (threadIdx.x == 0) {
        unsigned* bar = b.bar;
        __builtin_amdgcn_s_waitcnt(0);
        unsigned nloc = b.st[0], nx = b.st[1];
        if (nloc == 0u) { xcd_barrier_complete(bar, b.x, nloc, nx); b.st[0] = nloc; b.st[1] = nx; }
        const unsigned old = xb_add(&bar[XB_XSUB(b.x)], 1u);
        const unsigned gen = old / nloc;
        if (old + 1u == (gen + 1u) * nloc) {
            __builtin_amdgcn_fence(__ATOMIC_RELEASE, "agent");
            asm volatile("s_waitcnt vmcnt(0)" ::: "memory");
            const unsigned og = xb_add(&bar[XB_TOP], 1u);
            const unsigned tg = og / nx;
            if (og + 1u == (tg + 1u) * nx) xb_add(&bar[XB_TOPGEN], 1u);
            else XB_SPIN(xb_ld(&bar[XB_TOPGEN]) == tg, bar);
            __builtin_amdgcn_fence(__ATOMIC_ACQUIRE, "agent");
            xb_add(&bar[XB_XGEN(b.x)], 1u);
            asm volatile("s_waitcnt vmcnt(0)" ::: "memory");
        } else {
            XB_SPIN(xb_ld(&bar[XB_XGEN(b.x)]) == gen, bar);
            __builtin_amdgcn_fence(__ATOMIC_ACQUIRE, "agent");
            asm volatile("s_waitcnt vmcnt(0)" ::: "memory");
        }
    }
    __syncthreads();
}

__device__ __forceinline__ int w1t_src_col(int nt) {
    if (nt < 64) return nt * 64;
    const int t = nt - 64, pn = t >> 2, sub = t & 3;
    return pn < 8 ? (sub < 2 ? 4096 + 128 * pn + 64 * sub : 6144 + 128 * pn + 64 * (sub - 2)) : 5120 + 256 * (pn - 8) + 64 * sub;
}
struct TrTile { const float* src; bf16_t* dst; };
__device__ __forceinline__ void weight_transposes(const Params& p, unsigned char* lds) {
    bf16_t* T = (bf16_t*)lds;
    bf16_t* W1T = (bf16_t*)(p.ws + WS_W1T); bf16_t* W2T = (bf16_t*)(p.ws + WS_W2T);
    const int tid = threadIdx.x, G = gridDim.x;
    const int k = tid >> 3, nc = (tid & 7) * 4;
#define TR_DESC(t, SRC, LDSRC, DST, LDDST) do { if ((t) < 1792) { const int kt = (t) & 15, nt = (t) >> 4; SRC = p.in[2] + (size_t)(kt * 64) * DIN + w1t_src_col(nt); LDSRC = DIN; DST = W1T + (size_t)(nt * 64) * DM + kt * 64; LDDST = DM; } \
        else { const int u = (t) - 1792, kt = u & 31, nt = u >> 5; SRC = p.in[20] + (size_t)(kt * 64) * DM + nt * 64; LDSRC = DM; DST = W2T + (size_t)(nt * 64) * 2048 + ((kt * 64 + 1024) & 2047); LDDST = 2048; } } while (0)
    int t = blockIdx.x;
    if (t >= 1792 + 512) return;
    const float* src; bf16_t* dst; int ldsrc, lddst;
    TR_DESC(t, src, ldsrc, dst, lddst);
    float4 a = *(const float4*)(src + (size_t)k * ldsrc + nc), b = *(const float4*)(src + (size_t)k * ldsrc + nc + 32);
    for (; t < 1792 + 512; t += G) {
        T[(nc + 0) * 72 + k] = f2bf(a.x); T[(nc + 1) * 72 + k] = f2bf(a.y); T[(nc + 2) * 72 + k] = f2bf(a.z); T[(nc + 3) * 72 + k] = f2bf(a.w);
        T[(nc + 32) * 72 + k] = f2bf(b.x); T[(nc + 33) * 72 + k] = f2bf(b.y); T[(nc + 34) * 72 + k] = f2bf(b.z); T[(nc + 35) * 72 + k] = f2bf(b.w);
        bf16_t* dcur = dst; const int ldcur = lddst;
        const int tn = t + G;
        if (tn < 1792 + 512) { TR_DESC(tn, src, ldsrc, dst, lddst); a = *(const float4*)(src + (size_t)k * ldsrc + nc); b = *(const float4*)(src + (size_t)k * ldsrc + nc + 32); }
        __syncthreads();
        { const int n = tid >> 3, kc = (tid & 7) * 8;
          const uint4 v = *(const uint4*)(T + n * 72 + kc);
          *(uint4*)(dcur + (size_t)n * ldcur + kc) = v; }
        __syncthreads();
    }
#undef TR_DESC
}

__device__ __forceinline__ void lds_barrier0() { asm volatile("s_waitcnt lgkmcnt(0)" ::: "memory"); __builtin_amdgcn_s_barrier(); asm volatile("" ::: "memory"); }
__device__ __forceinline__ void half_barrier(unsigned* ctr, unsigned& ph) {
    asm volatile("s_waitcnt lgkmcnt(0)" ::: "memory");
    ph += 4u;
    if ((threadIdx.x & 63) == 0) __hip_atomic_fetch_add(ctr, 1u, __ATOMIC_RELAXED, __HIP_MEMORY_SCOPE_WORKGROUP);
    while (__hip_atomic_load(ctr, __ATOMIC_RELAXED, __HIP_MEMORY_SCOPE_WORKGROUP) < ph) __builtin_amdgcn_s_sleep(1);
    asm volatile("" ::: "memory");
}
constexpr int FR = 32;
constexpr int FT = 256;
__device__ __forceinline__ void filter_job(const Params& p, int job, unsigned char* lds, unsigned* hctr, unsigned& hph) {
    float* WL1 = (float*)lds; float* WL2 = WL1 + 33 * 64; float* WL3 = WL2 + 64 * 64;
    float* Z = WL3 + 64 * 64;
    float* HA = Z + FR * 33 + 32;
    float* HB = HA + FR * 64;
    const int tid = threadIdx.x, t0 = job * FR;
    const float* b1 = p.in[6]; const float* f1 = p.in[7];
    const float* b2 = p.in[9]; const float* f2 = p.in[10];
    const float* b3 = p.in[12]; const float* f3 = p.in[13];
    const float* wo = p.in[14];
    float* kraw = (float*)((unsigned char*)p.out + 64 * MiB);
    for (int e = tid; e < FR * 33; e += FT) {
        const int r = e / 33, i = e % 33; const int t = t0 + r;
        const float tn = (float)t / (float)(SEQ - 1);
        float v;
        if (i == 0) v = tn;
        else {
            const int band = (i - 1) & 15;
            const float f = 1e-4f + (float)band * ((15.0f - 1e-4f) / 15.0f);
            const float a2 = 2.0f * f * ((float)t / (float)SEQ);
            v = (i <= 16) ? cospif(a2) : -sinpif(a2);
        }
        Z[r * 33 + i] = v;
    }
    half_barrier(hctr, hph);
#pragma unroll 2
    for (int it = 0; it < FR * 64 / FT; ++it) {
        const int e = tid + it * FT, r = e >> 6, j = e & 63; float s = b1[j];
#pragma unroll 11
        for (int i = 0; i < 33; ++i) s += Z[r * 33 + i] * WL1[i * 64 + j];
        HA[r * 64 + j] = sinpif(f1[j] * s * 0.31830988618379067f);
    }
    half_barrier(hctr, hph);
#pragma unroll 2
    for (int it = 0; it < FR * 64 / FT; ++it) {
        const int e = tid + it * FT, r = e >> 6, j = e & 63; float s = b2[j];
#pragma unroll 16
        for (int i = 0; i < 64; ++i) s += HA[r * 64 + i] * WL2[i * 64 + j];
        HB[r * 64 + j] = sinpif(f2[j] * s * 0.31830988618379067f);
    }
    half_barrier(hctr, hph);
#pragma unroll 2
    for (int it = 0; it < FR * 64 / FT; ++it) {
        const int e = tid + it * FT, r = e >> 6, j = e & 63; float s = b3[j];
#pragma unroll 16
        for (int i = 0; i < 64; ++i) s += HB[r * 64 + i] * WL3[i * 64 + j];
        HA[r * 64 + j] = sinpif(f3[j] * s * 0.31830988618379067f);
    }
    half_barrier(hctr, hph);
    const float da = -3.0701134573253945f, db = -15.350567286626973f;
    typedef float f32x16 __attribute__((ext_vector_type(16)));
    const int lane = tid & 63, wave = tid >> 6, l31 = lane & 31, lh = lane >> 5;
    float af[32];
#pragma unroll
    for (int i = 0; i < 32; ++i) af[i] = HA[l31 * 64 + 2 * i + lh];
#pragma unroll 1
    for (int tile = 0; tile < 16; ++tile) {
        const int n = wave * 512 + tile * 32 + l31;
        float bv[32];
#pragma unroll
        for (int i = 0; i < 32; ++i) bv[i] = wo[(2 * i + lh) * 2048 + n];
        f32x16 acc;
#pragma unroll
        for (int i = 0; i < 16; ++i) acc[i] = 0.f;
#pragma unroll
        for (int i = 0; i < 32; ++i) acc = __builtin_amdgcn_mfma_f32_32x32x2f32(af[i], bv[i], acc, 0, 0, 0);
        const int cl = n & 1023;
        const float delta = fabsf(da + (db - da) * ((float)cl / 1023.0f));
        float* ST = (float*)(lds + 65536) + wave * (32 * 36);
#pragma unroll
        for (int i4 = 0; i4 < 4; ++i4) {
            const int tb = 8 * i4 + 4 * lh; float4 v;
            v.x = acc[4 * i4 + 0] * __expf(-((float)(t0 + tb + 0) / (float)(SEQ - 1)) * delta); v.y = acc[4 * i4 + 1] * __expf(-((float)(t0 + tb + 1) / (float)(SEQ - 1)) * delta);
            v.z = acc[4 * i4 + 2] * __expf(-((float)(t0 + tb + 2) / (float)(SEQ - 1)) * delta); v.w = acc[4 * i4 + 3] * __expf(-((float)(t0 + tb + 3) / (float)(SEQ - 1)) * delta);
            *(float4*)(ST + l31 * 36 + tb) = v;
        }
        const int nb = wave * 512 + tile * 32, half = nb >> 10, cb0 = nb & 1023;
#pragma unroll
        for (int ps = 0; ps < 4; ++ps) {
            const int rowi = ps * 8 + (lane >> 3), ch4 = (lane & 7) * 4, c = cb0 + rowi;
            const float4 v = *(const float4*)(ST + rowi * 36 + ch4);
            *(float4*)(kraw + (size_t)c * FFT_N + ((half * SEQ + t0 + ch4 + 64 * c) & (FFT_N - 1))) = v;
        }
    }
}

__device__ __forceinline__ void phase0(const Params& p, unsigned char* lds, int parts) {
    const int tid = threadIdx.x, lane = tid & 63, wave = tid >> 6, G = gridDim.x, bid = blockIdx.x;
    if (parts & 1) {
        unsigned* hctr = (unsigned*)(lds + LDS_ST_OFF) + 2;
        if (wave < 4) {
            if (bid < SEQ / FR) {
                unsigned hph = 0u;
                float* WL = (float*)lds;
                for (int i = tid; i < 33 * 64; i += FT) WL[i] = p.in[5][i];
                for (int i = tid; i < 64 * 64; i += FT) { WL[33 * 64 + i] = p.in[8][i]; WL[33 * 64 + 64 * 64 + i] = p.in[11][i]; }
                half_barrier(hctr, hph);
                for (int job = bid; job < SEQ / FR; job += G) { filter_job(p, job, lds, hctr, hph); half_barrier(hctr, hph); }
            }
        } else {
            bf16_t* hn = (bf16_t*)p.out; const float* x = p.in[0]; const float* w = p.in[1];
            int row = bid * 4 + (wave - 4); float4 nx[4], nx2[4];
#pragma unroll
            for (int i = 0; i < 4; ++i) nx[i] = *(const float4*)(x + (size_t)row * DM + i * 256 + lane * 4);
            if (row + G * 4 < MTOK) {
#pragma unroll
                for (int i = 0; i < 4; ++i) nx2[i] = *(const float4*)(x + (size_t)(row + G * 4) * DM + i * 256 + lane * 4);
            }
            for (; row < MTOK; row += G * 4) {
                float4 v[4]; float ss = 0.f;
#pragma unroll
                for (int i = 0; i < 4; ++i) { v[i] = nx[i]; nx[i] = nx2[i]; }
                const int rn = row + G * 8;
                if (rn < MTOK) {
#pragma unroll
                    for (int i = 0; i < 4; ++i) nx2[i] = *(const float4*)(x + (size_t)rn * DM + i * 256 + lane * 4);
                }
#pragma unroll
                for (int i = 0; i < 4; ++i) ss += v[i].x * v[i].x + v[i].y * v[i].y + v[i].z * v[i].z + v[i].w * v[i].w;
                ss = wave_sum(ss);
                const float r = rsqrtf(ss * (1.0f / DM) + EPSF);
#pragma unroll
                for (int i = 0; i < 4; ++i) { const float4 ww = *(const float4*)(w + i * 256 + lane * 4);
                    uint2 o; o.x = pk_bf16(v[i].x * r * ww.x, v[i].y * r * ww.y); o.y = pk_bf16(v[i].z * r * ww.z, v[i].w * r * ww.w);
                    *(uint2*)(hn + (size_t)row * DM + i * 256 + lane * 4) = o; }
            }
        }
        __syncthreads();
        if (tid == 0) *hctr = 0u;
        __syncthreads();
    }
    if (parts & 2) weight_transposes(p, lds);
    if (parts & 2) { bf16_t* sgw = (bf16_t*)(p.ws + WS_SGW); const float* s = p.in[18];
      for (int i = bid * NT + tid; i < 8 * 128 * 128; i += G * NT) sgw[i] = f2bf(s[i]);
      cf* tw = (cf*)(p.ws + WS_TW);
      for (int i = bid * NT + tid; i < 2048; i += G * NT) { float sn, cs; sincospif(-2.0f * (float)i / (float)FFT_N, &sn, &cs); tw[i] = cf{cs, sn}; } }
}

struct EpiHyT {
    static constexpr bool PERM = false, AFTER_DRAIN = false, SWAP = true;
    bf16_t* O;
    unsigned char* st;
    __device__ __forceinline__ void operator()(const pg8::f32x4 (&acc)[2][2][4][2], const pg8::Unit& u, int wr, int wc, int fr, int fq) const {
        const int lane = fq * 16 + fr;
        unsigned char* S = st + (wr * 4 + wc) * 2304;
        const int row0 = u.pm * 256 + wr * 64, b = row0 >> 13, tb = row0 & (SEQ - 1);
        const int rrow = lane >> 3, rchk = lane & 7;
#pragma unroll
        for (int ai = 0; ai < 2; ++ai)
#pragma unroll
            for (int bj = 0; bj < 2; ++bj)
#pragma unroll
                for (int n = 0; n < 2; ++n) {
#pragma unroll
                    for (int m = 0; m < 4; ++m) { const pg8::f32x4 v = acc[ai][bj][m][n]; uint2 o; o.x = pk_bf16(v[0], v[1]); o.y = pk_bf16(v[2], v[3]);
                        *(uint2*)(S + fr * 144 + (16 * m + 4 * fq) * 2) = o; }
#pragma unroll
                    for (int ps = 0; ps < 2; ++ps) { const int r = ps * 8 + rrow; const uint4 v = *(const uint4*)(S + r * 144 + rchk * 16);
                        const int ch = u.pn * 256 + bj * 128 + wc * 32 + n * 16 + r;
                        *(uint4*)(O + ((size_t)b * NHY + ch) * SEQ + tb + ai * 128 + rchk * 8) = v; }
                }
    }
};

struct EpiSg {
    static constexpr bool PERM = true, AFTER_DRAIN = false, SWAP = false;
    bf16_t* O;
    __device__ __forceinline__ void operator()(const pg8::f32x4 (&acc)[2][2][4][2], const pg8::Unit& u, int wr, int wc, int fr, int fq) const {
        const int row0 = u.pm * 256 + wr * 64 + fr;
        if (u.pn < 8) {
            const int col0 = u.pn * 128 + wc * 32 + 8 * fq;
#pragma unroll
            for (int ai = 0; ai < 2; ++ai)
#pragma unroll
                for (int m = 0; m < 4; ++m) { bf16_t* rowp = O + (size_t)(row0 + ai * 128 + m * 16) * NSG + col0;
                    const pg8::f32x4 u0 = acc[ai][0][m][0], u1 = acc[ai][0][m][1], g0 = acc[ai][1][m][0], g1 = acc[ai][1][m][1];
                    uint4 w; w.x = pk_bf16(u0[0] * siluf(g0[0]), u0[1] * siluf(g0[1])); w.y = pk_bf16(u0[2] * siluf(g0[2]), u0[3] * siluf(g0[3]));
                    w.z = pk_bf16(u1[0] * siluf(g1[0]), u1[1] * siluf(g1[1])); w.w = pk_bf16(u1[2] * siluf(g1[2]), u1[3] * siluf(g1[3]));
                    *(uint4*)rowp = w; }
        } else {
            const int col0 = 1024 + (u.pn - 8) * 256 + wc * 32 + 8 * fq;
#pragma unroll
            for (int ai = 0; ai < 2; ++ai)
#pragma unroll
                for (int m = 0; m < 4; ++m) { bf16_t* rowp = O + (size_t)(row0 + ai * 128 + m * 16) * NSG + col0;
#pragma unroll
                    for (int bj = 0; bj < 2; ++bj) { const pg8::f32x4 v0 = acc[ai][bj][m][0], v1 = acc[ai][bj][m][1];
                        uint4 w; w.x = pk_bf16(v0[0], v0[1]); w.y = pk_bf16(v0[2], v0[3]); w.z = pk_bf16(v1[0], v1[1]); w.w = pk_bf16(v1[2], v1[3]);
                        *(uint4*)(rowp + bj * 128) = w; } }
        }
    }
};

__device__ __forceinline__ void lds_barrier() { asm volatile("s_waitcnt lgkmcnt(0)" ::: "memory"); __builtin_amdgcn_s_barrier(); asm volatile("" ::: "memory"); }
template <int MODE>
__device__ __forceinline__ void fft_fwd3(cf* X, const cf* tw, int tid) {
    fft_stage<32, false, 512, 1, MODE>(X, tw, tid, NT); lds_barrier();
    fft_stage<32, false, 16, 32>(X, tw, tid, NT); lds_barrier();
}
__device__ __forceinline__ void fft_inv3(cf* X, const cf* tw, int tid) {
    fft_stage<32, true, 16, 32>(X, tw, tid, NT); lds_barrier();
    fft_stage<32, true, 512, 1, 2>(X, tw, tid, NT); lds_barrier();
}
struct Raw8 { uint4 q; bf16_t lo, hi; };
__device__ __forceinline__ Raw8 load_raw8(const bf16_t* row, int t0) {
    const int lane = threadIdx.x & 63;
    Raw8 r; r.q = *(const uint4*)(row + t0); r.lo = (bf16_t)0; r.hi = (bf16_t)0;
    if (lane == 0 && t0 > 0) r.lo = row[t0 - 1];
    if (lane == 63 && t0 + 8 < SEQ) r.hi = row[t0 + 8];
    return r;
}
__device__ __forceinline__ void conv8r(const Raw8& r, float w0, float w1, float w2, float bias, float (&o)[8]) {
    const int lane = threadIdx.x & 63;
    const unsigned prev = __shfl_up(r.q.w >> 16, 1), next = __shfl_down(r.q.x & 0xffffu, 1);
    float v[10];
    v[0] = __uint_as_float((lane == 0 ? (unsigned)r.lo : prev) << 16);
    v[1] = bf_lo(r.q.x); v[2] = bf_hi(r.q.x); v[3] = bf_lo(r.q.y); v[4] = bf_hi(r.q.y); v[5] = bf_lo(r.q.z); v[6] = bf_hi(r.q.z); v[7] = bf_lo(r.q.w); v[8] = bf_hi(r.q.w);
    v[9] = __uint_as_float((lane == 63 ? (unsigned)r.hi : next) << 16);
#pragma unroll
    for (int j = 0; j < 8; ++j) o[j] = v[j] * w0 + v[j + 1] * w1 + v[j + 2] * w2 + bias;
}
struct RawU { Raw8 v0[2], x0[2], v1[2], x1[2]; };
__device__ __forceinline__ void hyena_job(const Params& p, int c, unsigned char* lds, bool dry = false) {
    cf* X = (cf*)lds; float* red = (float*)(lds + FFT_LDS_CF * 8);
    const int tid = threadIdx.x, lane = tid & 63, wave = tid >> 6;
    const cf* tw = (const cf*)(lds + FFT_LDS_CF * 8 + 1024);
    bf16_t* HYT = (bf16_t*)(p.ws + WS_HYT);
    const float* cw = p.in[3]; const float* cb = p.in[4];
    float4* ks = (float4*)(p.ws + WS_KSCR) + (size_t)blockIdx.x * (FFT_N / 2);
    RawU ru;
#define LOAD_RU(PAIR) do { const bf16_t* _v0 = HYT + ((size_t)(2 * (PAIR)) * NHY + 2048 + c) * SEQ; const bf16_t* _v1 = _v0 + (size_t)NHY * SEQ; \
        const bf16_t* _x0 = HYT + ((size_t)(2 * (PAIR)) * NHY + 1024 + c) * SEQ; const bf16_t* _x1 = _x0 + (size_t)NHY * SEQ; \
        _Pragma("unroll") for (int it = 0; it < 2; ++it) { const int t0 = (tid + it * NT) * 8; \
            ru.v0[it] = load_raw8(_v0, t0); ru.x0[it] = load_raw8(_x0, t0); ru.v1[it] = load_raw8(_v1, t0); ru.x1[it] = load_raw8(_x1, t0); } } while (0)
    LOAD_RU(0);
    { const float* kr = (const float*)((const unsigned char*)p.out + 64 * MiB) + (size_t)c * FFT_N;
      float4 kv[8];
#pragma unroll
      for (int it = 0; it < 8; ++it) kv[it] = *(const float4*)(kr + ((tid * 4 + it * (NT * 4) + 64 * c) & (FFT_N - 1)));
      float l1 = 0.f;
#pragma unroll
      for (int it = 0; it < 8; ++it) { const float4 v = kv[it]; const int i = tid * 4 + it * (NT * 4);
          if (it < 4) {
              l1 += fabsf(v.x) + fabsf(v.y) + fabsf(v.z) + fabsf(v.w);
              const int pi = PADI(i); X[pi] = cf{v.x, 0.f}; X[pi + 1] = cf{v.y, 0.f}; X[pi + 2] = cf{v.z, 0.f}; X[pi + 3] = cf{v.w, 0.f};
          } else {
              const int m = i - SEQ;
              l1 += (m == 0 ? 0.f : fabsf(v.x)) + fabsf(v.y) + fabsf(v.z) + fabsf(v.w);
              X[PADI(m == 0 ? SEQ : FFT_N - m)] = cf{m == 0 ? 0.f : v.x, 0.f};
              const int pb = PADI(FFT_N - m - 3); X[pb + 2] = cf{v.y, 0.f}; X[pb + 1] = cf{v.z, 0.f}; X[pb] = cf{v.w, 0.f};
          } }
      l1 = wave_sum(l1); if (lane == 0) red[wave] = l1;
      lds_barrier();
      float tot = 0.f;
#pragma unroll
      for (int i = 0; i < 8; ++i) tot += red[i];
      fft_fwd3<0>(X, tw, tid);
      const float sc = 1.0f / ((tot + EPSF) * (float)FFT_N), sk = p.in[15][c] * (1.0f / (float)FFT_N);
#pragma unroll 1
      for (int g = tid; g < FFT_N / 16; g += NT) {
          const int pb = PADI(g * 16); cf a[16];
#pragma unroll
          for (int j = 0; j < 16; ++j) a[j] = X[pb + j];
          dft16<false>(a);
#pragma unroll
          for (int j = 0; j < 16; j += 2) (ks + (j >> 1) * (FFT_N / 16))[(unsigned)g] = make_float4(a[j].x * sc + sk, a[j].y * sc, a[j + 1].x * sc + sk, a[j + 1].y * sc);
      }
      asm volatile("s_waitcnt vmcnt(0)" ::: "memory");
      __syncthreads();
      __builtin_amdgcn_fence(__ATOMIC_ACQUIRE, "agent");
    }
    const float x0w0 = cw[c], x0w1 = cw[3072 + c], x0w2 = cw[6144 + c], x0b = cb[c];
    const float x1w0 = cw[1024 + c], x1w1 = cw[3072 + 1024 + c], x1w2 = cw[6144 + 1024 + c], x1b = cb[1024 + c];
    const float vw0 = cw[2048 + c], vw1 = cw[3072 + 2048 + c], vw2 = cw[6144 + 2048 + c], vb = cb[2048 + c];
#pragma unroll
    for (int pair = 0; pair < 2; ++pair) {
        const int b0 = 2 * pair, b1 = b0 + 1;
        bf16_t* vr0 = HYT + ((size_t)b0 * NHY + 2048 + c) * SEQ; bf16_t* vr1 = HYT + ((size_t)b1 * NHY + 2048 + c) * SEQ;
        bf16_t* yo0 = dry ? (bf16_t*)p.out + ((size_t)b0 * 1024 + c) * SEQ : vr0; bf16_t* yo1 = dry ? (bf16_t*)p.out + ((size_t)b1 * 1024 + c) * SEQ : vr1;
        {
#pragma unroll
            for (int it = 0; it < 2; ++it) { const int t0 = (tid + it * NT) * 8; float a[8], b[8], u0[8], u1[8];
                conv8r(ru.v0[it], vw0, vw1, vw2, vb, a); conv8r(ru.x0[it], x1w0, x1w1, x1w2, x1b, b);
#pragma unroll
                for (int j = 0; j < 8; ++j) u0[j] = a[j] * b[j];
                conv8r(ru.v1[it], vw0, vw1, vw2, vb, a); conv8r(ru.x1[it], x1w0, x1w1, x1w2, x1b, b);
#pragma unroll
                for (int j = 0; j < 8; ++j) u1[j] = a[j] * b[j];
                const int pi = PADI(t0);
#pragma unroll
                for (int j = 0; j < 8; ++j) X[pi + j] = cf{u0[j], u1[j]}; }
        }
        lds_barrier();
        fft_fwd3<1>(X, tw, tid);
        {
#pragma unroll 1
            for (int h = 0; h < 2; ++h) {
                const unsigned g = (unsigned)(tid + h * NT);
                float4 kk[8];
#pragma unroll
                for (int q = 0; q < 8; ++q) kk[q] = (ks + q * (FFT_N / 16))[g];
                const int pb = PADI((int)g * 16); cf a[16], b[16];
#pragma unroll
                for (int j = 0; j < 16; ++j) a[j] = X[pb + j];
                dft16<false>(a);
#pragma unroll
                for (int j = 0; j < 16; ++j) { const float4 k4 = kk[j >> 1]; const cf k = (j & 1) ? cf{k4.z, k4.w} : cf{k4.x, k4.y}; b[KIDX<16>(j)] = cmul(a[j], k); }
                dft16<true>(b);
#pragma unroll
                for (int j = 0; j < 16; ++j) X[pb + KIDX<16>(j)] = b[j];
            }
        }
        const bf16_t* x0r0 = HYT + ((size_t)b0 * NHY + c) * SEQ; const bf16_t* x0r1 = HYT + ((size_t)b1 * NHY + c) * SEQ;
        const bf16_t* gr0 = HYT + ((size_t)b0 * NHY + 3072 + c) * SEQ; const bf16_t* gr1 = HYT + ((size_t)b1 * NHY + 3072 + c) * SEQ;
        Raw8 r0[2], r1[2]; uint4 g0[2], g1[2];
#pragma unroll
        for (int it = 0; it < 2; ++it) { const int t0 = (tid + it * NT) * 8;
            r0[it] = load_raw8(x0r0, t0); r1[it] = load_raw8(x0r1, t0); g0[it] = *(const uint4*)(gr0 + t0); g1[it] = *(const uint4*)(gr1 + t0); }
        lds_barrier();
        fft_inv3(X, tw, tid);
        if (pair == 0) LOAD_RU(1);
        {
#pragma unroll
            for (int it = 0; it < 2; ++it) { const int t0 = (tid + it * NT) * 8, pi = PADI(t0); float a[8], y[8];
                { conv8r(r0[it], x0w0, x0w1, x0w2, x0b, a); const uint4 g = g0[it];
                  const float gg[8] = {bf_lo(g.x), bf_hi(g.x), bf_lo(g.y), bf_hi(g.y), bf_lo(g.z), bf_hi(g.z), bf_lo(g.w), bf_hi(g.w)};
#pragma unroll
                  for (int j = 0; j < 8; ++j) y[j] = a[j] * X[pi + j].x * siluf(gg[j]);
                  uint4 o; o.x = pk_bf16(y[0], y[1]); o.y = pk_bf16(y[2], y[3]); o.z = pk_bf16(y[4], y[5]); o.w = pk_bf16(y[6], y[7]);
                  *(uint4*)(yo0 + t0) = o; }
                { conv8r(r1[it], x0w0, x0w1, x0w2, x0b, a); const uint4 g = g1[it];
                  const float gg[8] = {bf_lo(g.x), bf_hi(g.x), bf_lo(g.y), bf_hi(g.y), bf_lo(g.z), bf_hi(g.z), bf_lo(g.w), bf_hi(g.w)};
#pragma unroll
                  for (int j = 0; j < 8; ++j) y[j] = a[j] * X[pi + j].y * siluf(gg[j]);
                  uint4 o; o.x = pk_bf16(y[0], y[1]); o.y = pk_bf16(y[2], y[3]); o.z = pk_bf16(y[4], y[5]); o.w = pk_bf16(y[6], y[7]);
                  *(uint4*)(yo1 + t0) = o; } }
        }
        lds_barrier();
    }
}

#undef LOAD_RU
__device__ __forceinline__ uint4 gmlp_group(const bf16_t* vnT, const bf16x8 (&wf)[4], int g, int fr, int fq, float bias, uint4 u4) {
    constexpr int PITCH = 136;
    f32x4 acc0 = (f32x4){0.f, 0.f, 0.f, 0.f}, acc1 = (f32x4){0.f, 0.f, 0.f, 0.f};
    const int drow = 32 * g + 8 * (fr >> 2) + (fr & 3);
#pragma unroll
    for (int ks = 0; ks < 4; ++ks) { const int kq = (ks * 32 + fq * 8) ^ ((fr >> 2) << 4);
        const bf16x8 v0 = *(const bf16x8*)(vnT + drow * PITCH + kq), v1 = *(const bf16x8*)(vnT + (drow + 4) * PITCH + kq);
        acc0 = __builtin_amdgcn_mfma_f32_16x16x32_bf16(v0, wf[ks], acc0, 0, 0, 0); acc1 = __builtin_amdgcn_mfma_f32_16x16x32_bf16(v1, wf[ks], acc1, 0, 0, 0); }
    const float y0 = bf_lo(u4.x) * (acc0[0] + bias), y1 = bf_hi(u4.x) * (acc0[1] + bias), y2 = bf_lo(u4.y) * (acc0[2] + bias), y3 = bf_hi(u4.y) * (acc0[3] + bias);
    const float y4 = bf_lo(u4.z) * (acc1[0] + bias), y5 = bf_hi(u4.z) * (acc1[1] + bias), y6 = bf_lo(u4.w) * (acc1[2] + bias), y7 = bf_hi(u4.w) * (acc1[3] + bias);
    uint4 o; o.x = pk_bf16(y0, y1); o.y = pk_bf16(y2, y3); o.z = pk_bf16(y4, y5); o.w = pk_bf16(y6, y7);
    return o;
}
__device__ __forceinline__ uint4 swap8(uint4 v) {
    uint4 r; r.x = (unsigned)__shfl_xor((int)v.x, 8); r.y = (unsigned)__shfl_xor((int)v.y, 8); r.z = (unsigned)__shfl_xor((int)v.z, 8); r.w = (unsigned)__shfl_xor((int)v.w, 8); return r;
}
__device__ __forceinline__ uint4 sel4(bool c, uint4 a, uint4 b) { uint4 r; r.x = c ? a.x : b.x; r.y = c ? a.y : b.y; r.z = c ? a.z : b.z; r.w = c ? a.w : b.w; return r; }
__device__ __forceinline__ void gmlp_phase(const Params& p, unsigned char* lds, bool dry, int k0 = 0, int nk = 1 << 20) {
    constexpr int PITCH = 136;
    bf16_t* SG = (bf16_t*)(p.ws + WS_SG);
    const bf16_t* sgw = (const bf16_t*)(p.ws + WS_SGW);
    const int tid = threadIdx.x, lane = tid & 63, wave = tid >> 6, G = gridDim.x;
    const int q = tid >> 2, part = tid & 3;
    const int qs = q ^ (part << 4);
    const int fr = lane & 15, fq = lane >> 4, p0 = wave * 16;
    int j = blockIdx.x + G * k0;
    const int jmax = min(2048, (int)blockIdx.x + (nk >= (1 << 20) ? (1 << 24) : G * (k0 + nk)));
    if (j >= jmax) return;
    uint4 vq[4];
    { const bf16_t* src = SG + ((size_t)(j >> 3) * 128 + q) * NSG + 1024 + (j & 7) * 128 + part * 8;
#pragma unroll
      for (int i = 0; i < 4; ++i) vq[i] = *(const uint4*)(src + i * 32); }
    int buf = 0;
#pragma unroll 1
    for (; j < jmax; j += G, buf ^= 1) {
        const int chunk = j >> 3, h = j & 7;
        const size_t t0 = (size_t)chunk * 128;
        bf16_t* vnT = (bf16_t*)(lds + buf * (128 * PITCH * 2));
        uint4 la[2], lb[2]; bf16x8 wf[4];
        const int r7 = fr & 7, hi = fr >> 3;
        const size_t rowA = (t0 + p0 + r7) * NSG, rowB = rowA + 8 * (size_t)NSG;
#pragma unroll
        for (int gp = 0; gp < 2; ++gp) { const int d = h * 128 + 32 * (2 * gp + hi) + 8 * fq; la[gp] = *(const uint4*)(SG + rowA + d); lb[gp] = *(const uint4*)(SG + rowB + d); }
#pragma unroll
        for (int ks = 0; ks < 4; ++ks) wf[ks] = *(const bf16x8*)(sgw + ((size_t)h * 128 + p0 + fr) * 128 + ks * 32 + fq * 8);
        const float bias = p.in[19][h * 128 + p0 + fr];
        {
            float v[32];
#pragma unroll
            for (int i = 0; i < 4; ++i) { const uint4 w = vq[i];
                v[8 * i + 0] = bf_lo(w.x); v[8 * i + 1] = bf_hi(w.x); v[8 * i + 2] = bf_lo(w.y); v[8 * i + 3] = bf_hi(w.y);
                v[8 * i + 4] = bf_lo(w.z); v[8 * i + 5] = bf_hi(w.z); v[8 * i + 6] = bf_lo(w.w); v[8 * i + 7] = bf_hi(w.w); }
            const int jn = j + G;
            if (jn < jmax) { const bf16_t* src = SG + ((size_t)(jn >> 3) * 128 + q) * NSG + 1024 + (jn & 7) * 128 + part * 8;
#pragma unroll
                for (int i = 0; i < 4; ++i) vq[i] = *(const uint4*)(src + i * 32); }
            float s = 0.f;
#pragma unroll
            for (int i = 0; i < 32; ++i) s += v[i];
            s += __shfl_xor(s, 1); s += __shfl_xor(s, 2);
            const float mu = s * (1.0f / 128.0f);
            float qq = 0.f;
#pragma unroll
            for (int i = 0; i < 32; ++i) { const float d = v[i] - mu; qq += d * d; }
            qq += __shfl_xor(qq, 1); qq += __shfl_xor(qq, 2);
            const float rstd = rsqrtf(qq * (1.0f / 128.0f) + EPSF);
            const float* nw = p.in[16] + h * 128 + part * 8; const float* nb = p.in[17] + h * 128 + part * 8;
#pragma unroll
            for (int i = 0; i < 32; i += 4) { const int dd = 32 * (i >> 3) + (i & 7); const float4 w4 = *(const float4*)(nw + dd), b4 = *(const float4*)(nb + dd);
                vnT[(part * 8 + dd + 0) * PITCH + qs] = f2bf((v[i + 0] - mu) * rstd * w4.x + b4.x); vnT[(part * 8 + dd + 1) * PITCH + qs] = f2bf((v[i + 1] - mu) * rstd * w4.y + b4.y);
                vnT[(part * 8 + dd + 2) * PITCH + qs] = f2bf((v[i + 2] - mu) * rstd * w4.z + b4.z); vnT[(part * 8 + dd + 3) * PITCH + qs] = f2bf((v[i + 3] - mu) * rstd * w4.w + b4.w); }
        }
        lds_barrier();
#pragma unroll
        for (int gp = 0; gp < 2; ++gp) {
            const bool hb = hi != 0;
            const uint4 rcv = swap8(sel4(hb, la[gp], lb[gp]));
            const uint4 u0 = sel4(hb, rcv, la[gp]), u1 = sel4(hb, lb[gp], rcv);
            const uint4 yo0 = gmlp_group(vnT, wf, 2 * gp, fr, fq, bias, u0), yo1 = gmlp_group(vnT, wf, 2 * gp + 1, fr, fq, bias, u1);
            const uint4 rcv2 = swap8(sel4(hb, yo0, yo1));
            const uint4 oa = sel4(hb, rcv2, yo0), ob = sel4(hb, yo1, rcv2);
            const int d = h * 128 + 32 * (2 * gp + hi) + 8 * fq;
            if (dry) { *(uint4*)((bf16_t*)p.out + (t0 + p0 + r7) * 1024 + d) = oa; *(uint4*)((bf16_t*)p.out + (t0 + p0 + 8 + r7) * 1024 + d) = ob; }
            else { *(uint4*)(SG + rowA + d) = oa; *(uint4*)(SG + rowB + d) = ob; }
        }
    }
    __syncthreads();
}

__device__ __forceinline__ void ya_transpose_phase(const Params& p, unsigned char* lds) {
    const bf16_t* HYT = (const bf16_t*)(p.ws + WS_HYT); bf16_t* SG = (bf16_t*)(p.ws + WS_SG);
    const int tid = threadIdx.x, G = gridDim.x;
    const int c = tid >> 3, tc = (tid & 7) * 8;
    int tile = blockIdx.x, buf = 0;
    if (tile >= 8192) return;
#define YA_SRC(t) (HYT + ((size_t)((t) >> 11) * NHY + 2048 + (((t) >> 7) & 15) * 64 + c) * SEQ + ((t) & 127) * 64 + tc)
    uint4 v = *(const uint4*)YA_SRC(tile);
    for (; tile < 8192; tile += G, buf ^= 1) {
        bf16_t* T = (bf16_t*)lds + buf * (64 * 72);
        T[(tc + 0) * 72 + c] = (bf16_t)(v.x & 0xffff); T[(tc + 1) * 72 + c] = (bf16_t)(v.x >> 16); T[(tc + 2) * 72 + c] = (bf16_t)(v.y & 0xffff); T[(tc + 3) * 72 + c] = (bf16_t)(v.y >> 16);
        T[(tc + 4) * 72 + c] = (bf16_t)(v.z & 0xffff); T[(tc + 5) * 72 + c] = (bf16_t)(v.z >> 16); T[(tc + 6) * 72 + c] = (bf16_t)(v.w & 0xffff); T[(tc + 7) * 72 + c] = (bf16_t)(v.w >> 16);
        const int tn = tile + G;
        if (tn < 8192) v = *(const uint4*)YA_SRC(tn);
        lds_barrier();
        const int tt = tile & 127, ct = (tile >> 7) & 15, b = tile >> 11;
        { const int t = tid >> 3, cc = (tid & 7) * 8;
          const uint4 o = *(const uint4*)(T + t * 72 + cc);
          *(uint4*)(SG + ((size_t)b * SEQ + tt * 64 + t) * NSG + 1024 + ct * 64 + cc) = o; }
    }
#undef YA_SRC
    lds_barrier();
}

__device__ __forceinline__ void phase5(const Params& p) {
    const int tid = threadIdx.x, lane = tid & 63, wave = tid >> 6, G = gridDim.x, bid = blockIdx.x;
    const float* x = p.in[0]; const float* w = p.in[21]; float* out = p.out;
    const bf16_t* Y = (const bf16_t*)(p.ws + WS_HYT);
    float4 ww[4];
#pragma unroll
    for (int i = 0; i < 2; ++i)
#pragma unroll
        for (int hh = 0; hh < 2; ++hh) ww[i * 2 + hh] = *(const float4*)(w + i * 512 + lane * 8 + hh * 4);
    int row = bid * 8 + wave;
    uint4 nq[2]; float4 nxx[4];
#pragma unroll
    for (int i = 0; i < 2; ++i) { nq[i] = *(const uint4*)(Y + (size_t)row * DM + i * 512 + lane * 8);
#pragma unroll
        for (int hh = 0; hh < 2; ++hh) nxx[i * 2 + hh] = *(const float4*)(x + (size_t)row * DM + i * 512 + lane * 8 + hh * 4); }
    for (; row < MTOK; row += G * 8) {
        float* orow = out + (size_t)row * DM;
        uint4 q[2]; float4 xx[4]; float v[2][8]; float ss = 0.f;
#pragma unroll
        for (int i = 0; i < 2; ++i) q[i] = nq[i];
#pragma unroll
        for (int i = 0; i < 4; ++i) xx[i] = nxx[i];
        const int rn = row + G * 8;
        if (rn < MTOK) {
#pragma unroll
            for (int i = 0; i < 2; ++i) { nq[i] = *(const uint4*)(Y + (size_t)rn * DM + i * 512 + lane * 8);
#pragma unroll
                for (int hh = 0; hh < 2; ++hh) nxx[i * 2 + hh] = *(const float4*)(x + (size_t)rn * DM + i * 512 + lane * 8 + hh * 4); }
        }
#pragma unroll
        for (int i = 0; i < 2; ++i) { v[i][0] = bf_lo(q[i].x); v[i][1] = bf_hi(q[i].x); v[i][2] = bf_lo(q[i].y); v[i][3] = bf_hi(q[i].y);
            v[i][4] = bf_lo(q[i].z); v[i][5] = bf_hi(q[i].z); v[i][6] = bf_lo(q[i].w); v[i][7] = bf_hi(q[i].w);
#pragma unroll
            for (int j = 0; j < 8; ++j) ss += v[i][j] * v[i][j]; }
        ss = wave_sum(ss);
        const float r = rsqrtf(ss * (1.0f / DM) + EPSF);
#pragma unroll
        for (int i = 0; i < 2; ++i)
#pragma unroll
            for (int hh = 0; hh < 2; ++hh) { const int col = i * 512 + lane * 8 + hh * 4; const float4 wq = ww[i * 2 + hh], xq = xx[i * 2 + hh];
                float4 o; o.x = xq.x + v[i][hh * 4 + 0] * r * wq.x; o.y = xq.y + v[i][hh * 4 + 1] * r * wq.y; o.z = xq.z + v[i][hh * 4 + 2] * r * wq.z; o.w = xq.w + v[i][hh * 4 + 3] * r * wq.w;
                *(float4*)(orow + col) = o; }
    }
}

__global__ void __launch_bounds__(NT, 2) hyena_gmlp_fwd(Params p) {
    extern __shared__ __attribute__((aligned(16))) unsigned char lds[];
    cg::grid_group grid = cg::this_grid();
    const int G = gridDim.x, bid = blockIdx.x;
    PG8_LAS unsigned char* ldsl = (PG8_LAS unsigned char*)lds;
    if (threadIdx.x < 4) ((unsigned*)(lds + LDS_ST_OFF))[threadIdx.x] = 0u;
    __syncthreads();
    if (bid == 0) { unsigned* bw = (unsigned*)(p.ws + WS_BAR); for (int i = threadIdx.x; i < XCD_BAR_WORDS; i += NT) bw[i] = 0u; }

    phase0(p, lds, 7);
#if PROBE_REP == 21
    phase0(p, lds, 1);
#elif PROBE_REP == 22
    phase0(p, lds, 2);
#elif PROBE_REP == 23
    phase0(p, lds, 4);
#elif PROBE_REP == 1
    phase0(p, lds, 7);
#endif
    grid.sync();
    const XcdBarrier xbar = xcd_barrier_post((unsigned*)(p.ws + WS_BAR), (volatile XB_LAS unsigned*)(lds + LDS_ST_OFF));

#pragma unroll 1
    for (int rep = 0; rep < NREP(2); ++rep) {
        pg8::Gemm g{(const bf16_t*)p.out, (const bf16_t*)(p.ws + WS_W1T), MTOK, NHY, DM, DM};
        pg8::StaticOrder S; S.init(MTOK, NHY, G, bid);
        EpiHyT E{(bf16_t*)(p.ws + WS_HYT), lds + 131072};
        pg8::gemm_phase<EpiHyT, pg8::StaticOrder, GEMM_ALIGN, GEMM_SP2>(ldsl, g, S, E);
#if PROBE_REP == 12
        pg8::gemm_phase<EpiHyT, pg8::StaticOrder, GEMM_ALIGN, GEMM_SP2>(ldsl, g, S, E);
#endif
    }
#pragma unroll 1
    for (int rep = 0; rep < NREP(3); ++rep) {
        pg8::Gemm g{(const bf16_t*)p.out, (const bf16_t*)(p.ws + WS_W1T) + (size_t)NHY * DM, MTOK, NSG, DM, DM};
        pg8::StaticOrder S; S.init(MTOK, NSG, G, bid);
        EpiSg E{(bf16_t*)(p.ws + WS_SG)};
        pg8::gemm_phase<EpiSg, pg8::StaticOrder, GEMM_ALIGN, GEMM_SP2>(ldsl, g, S, E);
#if PROBE_REP == 13
        pg8::gemm_phase<EpiSg, pg8::StaticOrder, GEMM_ALIGN, GEMM_SP2>(ldsl, g, S, E);
#endif
    }
    xcd_barrier(xbar);

    { const cf* twg = (const cf*)(p.ws + WS_TW); cf* twl = (cf*)(lds + FFT_LDS_CF * 8 + 1024);
      for (int i = threadIdx.x; i < 2048; i += NT) twl[i] = twg[i];
      __syncthreads(); }
#if PROBE_REP == 4 || PROBE_REP == 5
#pragma unroll 1
    for (int rep = 0; rep < NREP(4); ++rep)
        for (int c = bid; c < 1024; c += G) hyena_job(p, c, lds, rep < NREP(4) - 1);
#pragma unroll 1
    for (int rep = 0; rep < NREP(5); ++rep)
        gmlp_phase(p, lds, rep < NREP(5) - 1);
#else
    {
        const int nhy = (1024 - bid + G - 1) / G, ngm = (2048 - bid + G - 1) / G;
        const int gper = (ngm + nhy - 1) / (nhy > 0 ? nhy : 1);
        const bool first = ((bid >> 3) & 1) != 0;
        int kdone = 0;
#pragma unroll 1
        for (int e = 0; e <= nhy; ++e) {
            int nk = 0;
            if ((e & 1) == 0 && (first ? (e < nhy) : (e > 0))) nk = 2 * gper;
            if (e == nhy) nk = ngm - kdone;
            if (nk > ngm - kdone) nk = ngm - kdone;
            if (nk > 0) gmlp_phase(p, lds, false, kdone, nk);
            kdone += nk;
            if (e < nhy) hyena_job(p, bid + G * e, lds, false);
        }
    }
#endif
    xcd_barrier(xbar);

#pragma unroll 1
    for (int rep = 0; rep < NREP(6); ++rep)
        ya_transpose_phase(p, lds);
    xcd_barrier(xbar);

#pragma unroll 1
    for (int rep = 0; rep < NREP(7); ++rep) {
        pg8::Gemm g{(const bf16_t*)(p.ws + WS_SG), (const bf16_t*)(p.ws + WS_W2T), MTOK, DM, 2048, NSG};
        pg8::StaticOrder S; S.init(MTOK, DM, G, bid);
        pg8::EpiBf16<0> E{(bf16_t*)(p.ws + WS_HYT), DM, nullptr, 0, 0};
        pg8::gemm_phase<pg8::EpiBf16<0>, pg8::StaticOrder, GEMM_ALIGN, GEMM_SP2>(ldsl, g, S, E);
#if PROBE_REP == 17
        pg8::gemm_phase<pg8::EpiBf16<0>, pg8::StaticOrder, GEMM_ALIGN, GEMM_SP2>(ldsl, g, S, E);
#endif
    }
    xcd_barrier(xbar);

#pragma unroll 1
    for (int rep = 0; rep < NREP(8); ++rep) phase5(p);
#if PROBE_REP == 9
    grid.sync(); grid.sync(); grid.sync(); grid.sync();
#endif
}

extern "C" void kernel_launch(void* const* d_in, const int* in_sizes, int n_in, void* d_out, int out_size, void* d_ws, size_t ws_size, hipStream_t stream) {
    static int grid_blocks = 0;
    if (grid_blocks == 0) {
        if (n_in != 22 || out_size != MTOK * DM || ws_size < WS_END) { fprintf(stderr, "kernel_launch: unexpected shapes (n_in %d out %d ws %zu need %zu)\n", n_in, out_size, ws_size, (size_t)WS_END); grid_blocks = -1; return; }
        int dev = 0, cus = 0, per_cu = 0;
        hipGetDevice(&dev);
        hipDeviceGetAttribute(&cus, hipDeviceAttributeMultiprocessorCount, dev);
        if (hipFuncSetAttribute((const void*)hyena_gmlp_fwd, hipFuncAttributeMaxDynamicSharedMemorySize, LDS_BYTES) != hipSuccess) { fprintf(stderr, "kernel_launch: hipFuncSetAttribute failed\n"); grid_blocks = -1; return; }
        if (hipOccupancyMaxActiveBlocksPerMultiprocessor(&per_cu, (const void*)hyena_gmlp_fwd, NT, LDS_BYTES) != hipSuccess || per_cu < 1) { fprintf(stderr, "kernel_launch: occupancy query says %d\n", per_cu); (void)hipGetLastError(); grid_blocks = -1; return; }
        grid_blocks = cus * per_cu;
        if (grid_blocks > 256) grid_blocks = 256;
    }
    if (grid_blocks < 0) return;
    Params p{};
    for (int i = 0; i < 22; ++i) p.in[i] = (const float*)d_in[i];
    p.out = (float*)d_out; p.ws = (unsigned char*)d_ws;
    void* args[] = {&p};
    hipError_t e = hipLaunchCooperativeKernel((const void*)hyena_gmlp_fwd, dim3(grid_blocks), dim3(NT), args, LDS_BYTES, stream);
    if (e != hipSuccess) fprintf(stderr, "cooperative launch failed: %s (grid %d)\n", hipGetErrorString(e), grid_blocks);
}
```

```cpp
#include <hip/hip_runtime.h>
#include <hip/hip_cooperative_groups.h>
#include <cstdio>
#include <cstdint>
namespace cg = cooperative_groups;

#define HD __host__ __device__ __forceinline__
typedef float cf __attribute__((ext_vector_type(2)));
constexpr int FFT_N = 16384;
constexpr int FFT_LDS_CF = FFT_N + (FFT_N >> 5) * 2 + (FFT_N >> 9) * 16;
HD int PADI(int i) { return i + ((i >> 5) << 1) + ((i >> 9) << 4); }
HD constexpr int PADOFF(int d) { return d + ((d >> 5) << 1) + ((d >> 9) << 4); }
HD cf cadd(cf a, cf b) { return a + b; }
HD cf csub(cf a, cf b) { return a - b; }
HD cf cmul(cf a, cf b) {
#if defined(__HIP_DEVICE_COMPILE__)
    cf t, r;
    asm("v_pk_mul_f32 %0, %1, %2 op_sel:[0,0] op_sel_hi:[0,1]" : "=v"(t) : "v"(a), "v"(b));
    asm("v_pk_fma_f32 %0, %1, %2, %3 op_sel:[1,1,0] op_sel_hi:[1,0,1] neg_lo:[0,1,0] neg_hi:[0,0,0]" : "=v"(r) : "v"(a), "v"(b), "v"(t));
    return r;
#else
    return cf{a.x * b.x - a.y * b.y, a.x * b.y + a.y * b.x};
#endif
}
template <bool INV> HD cf twc(cf a, float c, float s) { return INV ? __builtin_elementwise_fma(a.yx, cf{-s, s}, a * c) : __builtin_elementwise_fma(a.yx, cf{s, -s}, a * c); }
template <bool INV> HD cf mul_mi(cf a) { return INV ? cf{-a.y, a.x} : cf{a.y, -a.x}; }
template <bool INV> HD void dft4(cf& a0, cf& a1, cf& a2, cf& a3) {
    const cf t0 = cadd(a0, a2), t1 = csub(a0, a2), t2 = cadd(a1, a3), t3 = mul_mi<INV>(csub(a1, a3));
    a0 = cadd(t0, t2); a2 = csub(t0, t2); a1 = cadd(t1, t3); a3 = csub(t1, t3);
}
template <int R> HD constexpr int KIDX(int j) { return R == 32 ? ((j >> 3) + 4 * (((j & 7) >> 1) + 4 * (j & 1))) : R == 16 ? ((j >> 2) + 4 * (j & 3)) : ((j >> 1) + 4 * (j & 1)); }
template <int R> HD constexpr int JIDX(int k) { return R == 32 ? (8 * (k & 3) + 2 * ((k >> 2) & 3) + (k >> 4)) : R == 16 ? ((k >> 2) + 4 * (k & 3)) : (2 * (k & 3) + (k >> 2)); }
template <bool INV> HD void dft8r(cf& a0, cf& a1, cf& a2, cf& a3, cf& a4, cf& a5, cf& a6, cf& a7) {
    dft4<INV>(a0, a2, a4, a6);
    dft4<INV>(a1, a3, a5, a7);
    const float c = 0.70710678118654752f;
    a3 = twc<INV>(a3, c, c);
    a5 = mul_mi<INV>(a5);
    a7 = twc<INV>(a7, -c, c);
    { const cf e = a0, o = a1; a0 = cadd(e, o); a1 = csub(e, o); }
    { const cf e = a2, o = a3; a2 = cadd(e, o); a3 = csub(e, o); }
    { const cf e = a4, o = a5; a4 = cadd(e, o); a5 = csub(e, o); }
    { const cf e = a6, o = a7; a6 = cadd(e, o); a7 = csub(e, o); }
}
template <bool INV> HD void dft8(cf (&a)[8]) { dft8r<INV>(a[0], a[1], a[2], a[3], a[4], a[5], a[6], a[7]); }
template <bool INV> HD void dft8h(cf& a0, cf& a1, cf& a2, cf& a3, cf& a4, cf& a5, cf& a6, cf& a7) {
    dft4<INV>(a0, a2, a4, a6);
    dft4<INV>(a1, a3, a5, a7);
    const float c = 0.70710678118654752f;
    a3 = twc<INV>(a3, c, c);
    a5 = mul_mi<INV>(a5);
    a7 = twc<INV>(a7, -c, c);
    a0 = cadd(a0, a1); a2 = cadd(a2, a3); a4 = cadd(a4, a5); a6 = cadd(a6, a7);
}
template <bool INV> HD void dft16(cf (&a)[16]) {
#pragma unroll
    for (int s = 0; s < 4; ++s) dft4<INV>(a[s], a[s + 4], a[s + 8], a[s + 12]);
    const float c1 = 0.92387953251128674f, s1 = 0.38268343236508977f, c2 = 0.70710678118654752f;
    a[1 + 4] = twc<INV>(a[1 + 4], c1, s1);
    a[2 + 4] = twc<INV>(a[2 + 4], c2, c2);
    a[3 + 4] = twc<INV>(a[3 + 4], s1, c1);
    a[1 + 8] = twc<INV>(a[1 + 8], c2, c2);
    a[2 + 8] = mul_mi<INV>(a[2 + 8]);
    a[3 + 8] = twc<INV>(a[3 + 8], -c2, c2);
    a[1 + 12] = twc<INV>(a[1 + 12], s1, c1);
    a[2 + 12] = twc<INV>(a[2 + 12], -c2, c2);
    a[3 + 12] = twc<INV>(a[3 + 12], -c1, -s1);
#pragma unroll
    for (int k1 = 0; k1 < 4; ++k1) dft4<INV>(a[4 * k1], a[4 * k1 + 1], a[4 * k1 + 2], a[4 * k1 + 3]);
}
template <bool INV, int MODE> HD void dft32m(cf (&a)[32]) {
    constexpr float C32[22] = {1.000000000e+00f, 9.807852804e-01f, 9.238795325e-01f, 8.314696123e-01f, 7.071067812e-01f, 5.555702330e-01f, 3.826834324e-01f, 1.950903220e-01f, 0.000000000e+00f, -1.950903220e-01f, -3.826834324e-01f, -5.555702330e-01f, -7.071067812e-01f, -8.314696123e-01f, -9.238795325e-01f, -9.807852804e-01f, -1.000000000e+00f, -9.807852804e-01f, -9.238795325e-01f, -8.314696123e-01f, -7.071067812e-01f, -5.555702330e-01f};
    constexpr float S32[22] = {0.000000000e+00f, 1.950903220e-01f, 3.826834324e-01f, 5.555702330e-01f, 7.071067812e-01f, 8.314696123e-01f, 9.238795325e-01f, 9.807852804e-01f, 1.000000000e+00f, 9.807852804e-01f, 9.238795325e-01f, 8.314696123e-01f, 7.071067812e-01f, 5.555702330e-01f, 3.826834324e-01f, 1.950903220e-01f, 0.000000000e+00f, -1.950903220e-01f, -3.826834324e-01f, -5.555702330e-01f, -7.071067812e-01f, -8.314696123e-01f};
    if constexpr (MODE == 1) {
#pragma unroll
        for (int s = 0; s < 8; ++s) { const cf t0 = a[s], t3 = mul_mi<INV>(a[s + 8]); const cf t2 = a[s + 8];
            a[s] = cadd(t0, t2); a[s + 16] = csub(t0, t2); a[s + 8] = cadd(t0, t3); a[s + 24] = csub(t0, t3); }
    } else {
#pragma unroll
        for (int s = 0; s < 8; ++s) dft4<INV>(a[s], a[s + 8], a[s + 16], a[s + 24]);
    }
#pragma unroll
    for (int k1 = 1; k1 < 4; ++k1)
#pragma unroll
        for (int s = 1; s < 8; ++s) { const int e = s * k1;
            if (e == 8) a[s + 8 * k1] = mul_mi<INV>(a[s + 8 * k1]); else a[s + 8 * k1] = twc<INV>(a[s + 8 * k1], C32[e], S32[e]); }
#pragma unroll
    for (int k1 = 0; k1 < 4; ++k1) {
        if constexpr (MODE == 2) dft8h<INV>(a[8 * k1], a[8 * k1 + 1], a[8 * k1 + 2], a[8 * k1 + 3], a[8 * k1 + 4], a[8 * k1 + 5], a[8 * k1 + 6], a[8 * k1 + 7]);
        else dft8r<INV>(a[8 * k1], a[8 * k1 + 1], a[8 * k1 + 2], a[8 * k1 + 3], a[8 * k1 + 4], a[8 * k1 + 5], a[8 * k1 + 6], a[8 * k1 + 7]);
    }
}
template <bool INV> HD void dft32(cf (&a)[32]) { dft32m<INV, 0>(a); }
template <int R, bool INV> HD void dftR(cf (&a)[R]) { if constexpr (R == 32) dft32<INV>(a); else if constexpr (R == 16) dft16<INV>(a); else dft8<INV>(a); }
template <int R, bool INV, int S, int TWS, int MODE = 0, class XP, class TP>
HD void fft_stage(XP X, TP tw, int tid, int nthreads) {
    constexpr int NB = FFT_N / R;
#pragma unroll 2
    for (int g = tid; g < NB; g += nthreads) {
        const int np = g & (S - 1);
        const int base = (g - np) * R + np;
        const int pb = PADI(base);
        cf a[R];
#pragma unroll
        for (int j = 0; j < R; ++j) { if (MODE == 1 && j >= R / 2) a[j] = cf{0.f, 0.f}; else a[j] = X[pb + PADOFF(j * S)]; }
        cf w = cf{1.f, 0.f};
        if constexpr (TWS != 0) { w = tw[np * TWS]; if (INV) w.y = -w.y; }
        if constexpr (INV && TWS != 0) {
            cf p = w;
#pragma unroll
            for (int j = 1; j < R; ++j) { a[j] = cmul(a[j], p); p = cmul(p, w); }
        }
        if constexpr (R == 32 && MODE != 0) dft32m<INV, MODE>(a); else dftR<R, INV>(a);
        if constexpr (!INV && TWS != 0) {
            cf p = w;
#pragma unroll
            for (int k = 1; k < R; ++k) { a[JIDX<R>(k)] = cmul(a[JIDX<R>(k)], p); p = cmul(p, w); }
        }
#pragma unroll
        for (int j = 0; j < R; ++j) { if (MODE == 2 && KIDX<R>(j) >= R / 2) continue; X[pb + PADOFF(KIDX<R>(j) * S)] = a[j]; }
    }
}
namespace pg8 {
#define PG8_LAS __attribute__((address_space(3)))
typedef unsigned short bf16_t;
typedef short bf16x8 __attribute__((ext_vector_type(8)));
typedef float f32x4 __attribute__((ext_vector_type(4)));
typedef unsigned u32x4 __attribute__((ext_vector_type(4)));
constexpr int BM = 256, BK = 64, HALF = 128, HTB = HALF * BK * 2  , STAGE_BYTES = 8 * HTB, NXCD = 8, WGM = 8;

__host__ __device__ __forceinline__ int lds_byte(int r, int c) { const int st = (r >> 4) * 2 + (c >> 5), rr = r & 15, cc = c & 31, ob = rr * 64 + cc * 2; return st * 1024 + (ob ^ (((ob >> 9) & 1) << 5)); }
__host__ __device__ __forceinline__ void stage_rc(int b, int& R, int& C) { const int st = b / 1024, sb = b % 1024, swz = sb ^ (((sb >> 9) & 1) << 5); R = (st >> 1) * 16 + swz / 64; C = (st & 1) * 32 + (swz % 64) / 2; }
__host__ __device__ __forceinline__ int perm32(int rho) { const int n = rho >> 4, i = rho & 15; return 8 * (i >> 2) + 4 * n + (i & 3); }

struct Unit { int pm, pn; };
struct Gemm { const bf16_t* A; const bf16_t* Bt; int M, N, K, lda; };

struct StaticOrder {
    int nM, nN, nwg, G, c;
    __host__ __device__ void init(int M, int N, int G_, int c_) { nM = M / BM; nN = N / BM; nwg = nM * nN; G = G_; c = c_; }
    __host__ __device__ bool next(int i, Unit& u) const {
        const long L = (long)i * G + c; if (L >= nwg) return false;
        int wgid = (int)L; { const int q = nwg / NXCD, r = nwg % NXCD, xcd = wgid % NXCD, off = wgid / NXCD; wgid = (xcd < r ? xcd * (q + 1) : r * (q + 1) + (xcd - r) * q) + off; }
        const int nig = WGM * nN, gid = wgid / nig, fm = gid * WGM, gsz = (nM - fm) < WGM ? (nM - fm) : WGM;
        u.pm = fm + ((wgid % nig) % gsz); u.pn = (wgid % nig) / gsz; return true;
    }
    __device__ __forceinline__ void a_ready(const Unit&) const {}
    __device__ __forceinline__ void done(const Unit&) const {}
};
__device__ __forceinline__ unsigned cvt_pk_bf16(float lo, float hi) { unsigned r; asm volatile("v_cvt_pk_bf16_f32 %0, %1, %2" : "=v"(r) : "v"(lo), "v"(hi)); return r; }
typedef float f32x2 __attribute__((ext_vector_type(2)));
__device__ __forceinline__ f32x2 gelu_pk(f32x2 v) {
    const f32x2 av = __builtin_elementwise_abs(v), d = av * 0.2316418882f + 1.0f;
    f32x2 t; t.x = __builtin_amdgcn_rcpf(d.x); t.y = __builtin_amdgcn_rcpf(d.y);
    f32x2 q = t * 0.5307027145f + (-0.7265760135f); q = q * t + 0.7107068705f; q = q * t + (-0.142248368f); q = q * t + 0.127414796f; q = q * t;
    const f32x2 s = (v * v) * (-0.72134752044f);
    f32x2 e; e.x = __builtin_amdgcn_exp2f(s.x); e.y = __builtin_amdgcn_exp2f(s.y);
    const f32x2 m = v * (q * e), r = v - m;
    f32x2 o; o.x = v.x < 0.f ? m.x : r.x; o.y = v.y < 0.f ? m.y : r.y; return o;
}

struct EpiF32 {
    static constexpr bool PERM = false, AFTER_DRAIN = false, SWAP = false;
    float* C; int ldc; const float* bias;
    __device__ __forceinline__ void operator()(const f32x4 (&acc)[2][2][4][2], const Unit& u, int wr, int wc, int fr, int fq) const {
        const int row0 = u.pm * BM + wr * 64 + fr, col0 = u.pn * BM + wc * 32 + 4 * fq;
        f32x4 bv[2][2];
#pragma unroll
        for (int bj = 0; bj < 2; ++bj)
#pragma unroll
            for (int n = 0; n < 2; ++n) bv[bj][n] = bias ? *(const f32x4*)(bias + col0 + bj * HALF + n * 16) : (f32x4){0.f, 0.f, 0.f, 0.f};
#pragma unroll
        for (int ai = 0; ai < 2; ++ai)
#pragma unroll
            for (int m = 0; m < 4; ++m) { float* rowp = C + (size_t)(row0 + ai * HALF + m * 16) * ldc + col0;
#pragma unroll
                for (int bj = 0; bj < 2; ++bj)
#pragma unroll
                    for (int n = 0; n < 2; ++n) *(f32x4*)(rowp + bj * HALF + n * 16) = acc[ai][bj][m][n] + bv[bj][n]; }
    }
};
template <int ACT  > struct EpiBf16 {
    static constexpr bool PERM = true, AFTER_DRAIN = false, SWAP = false;
    bf16_t* O; int ldc; const float* bias; int split_cols; size_t split_stride;
    __device__ __forceinline__ void operator()(const f32x4 (&acc)[2][2][4][2], const Unit& u, int wr, int wc, int fr, int fq) const {
        const int row0 = u.pm * BM + wr * 64 + fr; int colt = u.pn * BM; bf16_t* base = O;
        if (split_cols) { const int t = colt / split_cols; base += (size_t)t * split_stride; colt -= t * split_cols; }
        const int col0 = colt + wc * 32 + 8 * fq, bcol0 = u.pn * BM + wc * 32 + 8 * fq;
        f32x4 bv[2][2];
#pragma unroll
        for (int bj = 0; bj < 2; ++bj)
#pragma unroll
            for (int n = 0; n < 2; ++n) bv[bj][n] = bias ? *(const f32x4*)(bias + bcol0 + bj * HALF + 4 * n) : (f32x4){0.f, 0.f, 0.f, 0.f};
#pragma unroll
        for (int ai = 0; ai < 2; ++ai)
#pragma unroll
            for (int m = 0; m < 4; ++m) { bf16_t* rowp = base + (size_t)(row0 + ai * HALF + m * 16) * ldc + col0;
#pragma unroll
                for (int bj = 0; bj < 2; ++bj) { f32x4 v0 = acc[ai][bj][m][0] + bv[bj][0], v1 = acc[ai][bj][m][1] + bv[bj][1];
                    if (ACT == 1) { f32x2 a = gelu_pk((f32x2){v0[0], v0[1]}), b = gelu_pk((f32x2){v0[2], v0[3]}), c = gelu_pk((f32x2){v1[0], v1[1]}), d = gelu_pk((f32x2){v1[2], v1[3]});
                        v0 = (f32x4){a.x, a.y, b.x, b.y}; v1 = (f32x4){c.x, c.y, d.x, d.y}; }
                    if (ACT == 2) {
#pragma unroll
                        for (int j = 0; j < 4; ++j) { v0[j] = 0.5f * v0[j] * (1.0f + erff(v0[j] * 0.70710678f)); v1[j] = 0.5f * v1[j] * (1.0f + erff(v1[j] * 0.70710678f)); } }
                    u32x4 w; w.x = cvt_pk_bf16(v0[0], v0[1]); w.y = cvt_pk_bf16(v0[2], v0[3]); w.z = cvt_pk_bf16(v1[0], v1[1]); w.w = cvt_pk_bf16(v1[2], v1[3]);
                    *(u32x4*)(rowp + bj * HALF) = w; } }
    }
};
template <class Epi, class Sched, bool ALIGN_EPI = false, bool SP2 = false>
__device__ __forceinline__ void gemm_phase(PG8_LAS unsigned char* lds, const Gemm g, const Sched& S, const Epi& E) {
    const int tid = threadIdx.x, wid = __builtin_amdgcn_readfirstlane(tid >> 6), lane = tid & 63, wr = wid >> 2, wc = wid & 3, fr = lane & 15, fq = lane >> 4;
    const int K = g.K, nt = K / BK;
    unsigned voffA[2], voffB[2];
#pragma unroll
    for (int i = 0; i < 2; ++i) { int R, C; stage_rc(tid * 16 + i * 8192, R, C); const int Rb = Epi::PERM ? ((R & ~31) + perm32(R & 31)) : R;
        voffA[i] = (unsigned)(R * g.lda + C) * 2u; voffB[i] = (unsigned)(Rb * K + C) * 2u; }
    const size_t kstep = (size_t)(BK * 2);
    const size_t hstepA = (size_t)HALF * g.lda * 2, hstepB = (size_t)HALF * K * 2;
    const size_t tstepA = 2 * hstepA, tstepB = 2 * hstepB;
    const unsigned ldsw = (unsigned)wid * 1024u;
    const int aoff = lds_byte(wr * 64 + fr, fq * 8), boff = lds_byte(wc * 32 + fr, fq * 8);
#define PG8_SA(b, h) (((b) * 2 + (h)) * HTB)
#define PG8_SB(b, h) ((4 + (b) * 2 + (h)) * HTB)
#define PG8_STAGE(bufoff, gbase, voff) do { _Pragma("unroll") for (int _i = 0; _i < 2; ++_i) \
        __builtin_amdgcn_global_load_lds((const unsigned*)((const char*)(gbase) + (voff)[_i]), (PG8_LAS unsigned*)(lds + (bufoff) + ldsw + _i * 8192), 16, 0, 0); } while (0)
#define PG8_LDA(dst, b, h) do { _Pragma("unroll") for (int m = 0; m < 4; ++m) _Pragma("unroll") for (int k = 0; k < 2; ++k) dst[m][k] = *(const PG8_LAS bf16x8*)(lds + PG8_SA(b, h) + aoff + m * 2048 + k * 1024); } while (0)
#define PG8_LDB(dst, b, h) do { _Pragma("unroll") for (int n = 0; n < 2; ++n) _Pragma("unroll") for (int k = 0; k < 2; ++k) dst[n][k] = *(const PG8_LAS bf16x8*)(lds + PG8_SB(b, h) + boff + n * 2048 + k * 1024); } while (0)
#define PG8_MMA(ai, bj, At, Bt) do { __builtin_amdgcn_s_setprio(1); _Pragma("unroll") for (int m = 0; m < 4; ++m) _Pragma("unroll") for (int n = 0; n < 2; ++n) _Pragma("unroll") for (int k = 0; k < 2; ++k) \
        acc[ai][bj][m][n] = Epi::SWAP ? __builtin_amdgcn_mfma_f32_16x16x32_bf16(At[m][k], Bt[n][k], acc[ai][bj][m][n], 0, 0, 0) : __builtin_amdgcn_mfma_f32_16x16x32_bf16(Bt[n][k], At[m][k], acc[ai][bj][m][n], 0, 0, 0); __builtin_amdgcn_s_setprio(0); } while (0)
#define PG8_WAIT_V(n) asm volatile("s_waitcnt vmcnt(" #n ")" ::: "memory")
#define PG8_WAIT_L(n) asm volatile("s_waitcnt lgkmcnt(" #n ")" ::: "memory")
#define PG8_BAR __builtin_amdgcn_s_barrier()
#define PG8_SCHED __builtin_amdgcn_sched_barrier(0)
    Unit cur, nxt; int ui = 0;
    if (!S.next(0, cur)) return;
    f32x4 acc[2][2][4][2];
#pragma unroll
    for (int a = 0; a < 2; ++a)
#pragma unroll
        for (int b = 0; b < 2; ++b)
#pragma unroll
            for (int m = 0; m < 4; ++m)
#pragma unroll
                for (int n = 0; n < 2; ++n) acc[a][b][m][n] = (f32x4){0.f, 0.f, 0.f, 0.f};
    bf16x8 At[4][2], B0[2][2], B1[2][2];
    const char* cA = (const char*)g.A + (size_t)cur.pm * tstepA; const char* cB = (const char*)g.Bt + (size_t)cur.pn * tstepB;
    S.a_ready(cur);
    if constexpr (SP2) {
        PG8_STAGE(PG8_SB(0, 0), cB, voffB); PG8_STAGE(PG8_SB(0, 1), cB + hstepB, voffB); PG8_STAGE(PG8_SA(0, 0), cA, voffA); PG8_STAGE(PG8_SA(0, 1), cA + hstepA, voffA);
        if (wr == 1) PG8_BAR;
        PG8_WAIT_V(2); PG8_BAR;
        PG8_STAGE(PG8_SB(1, 0), cB + kstep, voffB); PG8_STAGE(PG8_SA(1, 0), cA + kstep, voffA); PG8_STAGE(PG8_SB(1, 1), cB + hstepB + kstep, voffB);
        PG8_WAIT_V(6); PG8_BAR;
    } else {
        PG8_STAGE(PG8_SB(0, 0), cB, voffB); PG8_STAGE(PG8_SA(0, 0), cA, voffA); PG8_STAGE(PG8_SB(0, 1), cB + hstepB, voffB); PG8_STAGE(PG8_SA(0, 1), cA + hstepA, voffA);
        if (wr == 1) PG8_BAR;
        PG8_WAIT_V(4); PG8_BAR;
        PG8_STAGE(PG8_SB(1, 0), cB + kstep, voffB); PG8_STAGE(PG8_SA(1, 0), cA + kstep, voffA); PG8_STAGE(PG8_SB(1, 1), cB + hstepB + kstep, voffB);
        PG8_WAIT_V(6); PG8_BAR;
    }
    for (;;) {
        const bool has_next = S.next(ui + 1, nxt);
        const char* nA = has_next ? (const char*)g.A + (size_t)nxt.pm * tstepA : cA; const char* nB = has_next ? (const char*)g.Bt + (size_t)nxt.pn * tstepB : cB;
        for (int t = 0; t < nt; t += 2) {
            const bool last = (t == nt - 2);
            const char* a1 = cA + (size_t)(t + 1) * kstep;
            const char* a2 = last ? nA : cA + (size_t)(t + 2) * kstep; const char* b2 = last ? nB : cB + (size_t)(t + 2) * kstep;
            const char* a3 = a2 + kstep; const char* b3 = b2 + kstep;
            if (last && has_next) S.a_ready(nxt);
            if constexpr (SP2) {
            PG8_LDB(B0, 0, 0); PG8_LDB(B1, 0, 1); PG8_SCHED; PG8_LDA(At, 0, 0); PG8_STAGE(PG8_SA(1, 1), a1 + hstepA, voffA);
            PG8_WAIT_V(8); PG8_WAIT_L(0); PG8_BAR; PG8_MMA(0, 0, At, B0); PG8_MMA(0, 1, At, B1); PG8_BAR; PG8_SCHED;
            PG8_LDA(At, 0, 1); PG8_STAGE(PG8_SB(0, 0), b2, voffB); PG8_STAGE(PG8_SB(0, 1), b2 + hstepB, voffB); PG8_STAGE(PG8_SA(0, 0), a2, voffA);
            PG8_WAIT_V(8); PG8_WAIT_L(0); PG8_BAR; PG8_MMA(1, 0, At, B0); PG8_MMA(1, 1, At, B1); PG8_BAR; PG8_SCHED;
            PG8_LDB(B0, 1, 0); PG8_LDB(B1, 1, 1); PG8_SCHED; PG8_LDA(At, 1, 0); PG8_STAGE(PG8_SA(0, 1), a2 + hstepA, voffA);
            PG8_WAIT_V(8); PG8_WAIT_L(0); PG8_BAR; PG8_MMA(0, 0, At, B0); PG8_MMA(0, 1, At, B1); PG8_BAR; PG8_SCHED;
            PG8_LDA(At, 1, 1); PG8_STAGE(PG8_SB(1, 0), b3, voffB); PG8_STAGE(PG8_SB(1, 1), b3 + hstepB, voffB); PG8_STAGE(PG8_SA(1, 0), a3, voffA);
            PG8_WAIT_V(8); PG8_WAIT_L(0); PG8_BAR; PG8_MMA(1, 0, At, B0); PG8_MMA(1, 1, At, B1); PG8_BAR; PG8_SCHED;
            } else {
            PG8_LDB(B0, 0, 0); PG8_SCHED; PG8_LDA(At, 0, 0); PG8_STAGE(PG8_SA(1, 1), a1 + hstepA, voffA);
            PG8_WAIT_L(8); PG8_BAR; PG8_WAIT_L(0); PG8_MMA(0, 0, At, B0); PG8_BAR; PG8_SCHED;
            PG8_LDB(B1, 0, 1); PG8_STAGE(PG8_SB(0, 0), b2, voffB);
            PG8_BAR; PG8_WAIT_L(0); PG8_MMA(0, 1, At, B1); PG8_BAR;
            PG8_LDA(At, 0, 1); PG8_STAGE(PG8_SA(0, 0), a2, voffA);
            PG8_BAR; PG8_WAIT_L(0); PG8_MMA(1, 0, At, B0); PG8_BAR; PG8_SCHED;
            PG8_STAGE(PG8_SB(0, 1), b2 + hstepB, voffB);
            PG8_WAIT_V(6); PG8_BAR; PG8_MMA(1, 1, At, B1); PG8_BAR;
            PG8_LDB(B0, 1, 0); PG8_SCHED; PG8_LDA(At, 1, 0); PG8_STAGE(PG8_SA(0, 1), a2 + hstepA, voffA);
            PG8_WAIT_L(8); PG8_BAR; PG8_WAIT_L(0); PG8_MMA(0, 0, At, B0); PG8_BAR; PG8_SCHED;
            PG8_LDB(B1, 1, 1); PG8_STAGE(PG8_SB(1, 0), b3, voffB);
            PG8_BAR; PG8_WAIT_L(0); PG8_MMA(0, 1, At, B1); PG8_BAR;
            PG8_LDA(At, 1, 1); PG8_STAGE(PG8_SA(1, 0), a3, voffA);
            PG8_BAR; PG8_WAIT_L(0); PG8_MMA(1, 0, At, B0); PG8_BAR; PG8_SCHED;
            PG8_STAGE(PG8_SB(1, 1), b3 + hstepB, voffB);
            PG8_WAIT_V(6); PG8_BAR; PG8_MMA(1, 1, At, B1); PG8_BAR;
            }
        }
        if constexpr (ALIGN_EPI) { if (wr == 0) PG8_BAR; }
        if constexpr (!Epi::AFTER_DRAIN) { E(acc, cur, wr, wc, fr, fq); S.done(cur); }
        if (!has_next) break;
#pragma unroll
        for (int a = 0; a < 2; ++a)
#pragma unroll
            for (int b = 0; b < 2; ++b)
#pragma unroll
                for (int m = 0; m < 4; ++m)
#pragma unroll
                    for (int n = 0; n < 2; ++n) acc[a][b][m][n] = (f32x4){0.f, 0.f, 0.f, 0.f};
        cur = nxt; cA = nA; cB = nB; ++ui;
        if constexpr (ALIGN_EPI) { if (wr == 1) PG8_BAR; }
    }
    PG8_WAIT_V(0);
    if constexpr (!ALIGN_EPI) { if (wr == 0) PG8_BAR; }
    PG8_BAR;
    if constexpr (Epi::AFTER_DRAIN) { E.fused(acc, cur, wr, wc, fr, fq, lds, wid, lane); S.done(cur); }
#undef PG8_SA
#undef PG8_SB
#undef PG8_STAGE
#undef PG8_LDA
#undef PG8_LDB
#undef PG8_MMA
#undef PG8_WAIT_V
#undef PG8_WAIT_L
#undef PG8_BAR
#undef PG8_SCHED
}
}

#ifndef PROBE_REP
#define PROBE_REP 0
#endif
#define NREP(k) ((PROBE_REP == (k)) ? 2 : 1)
constexpr int NT = 512;
#ifndef GEMM_SP2
#define GEMM_SP2 true
#endif
#ifndef GEMM_ALIGN
#define GEMM_ALIGN true
#endif
constexpr int BATCH = 4, SEQ = 8192, DM = 1024, MTOK = BATCH * SEQ, DIN = 7168, NHY = 4096, NSG = 3072;
constexpr float EPSF = 1e-6f;
constexpr size_t MiB = 1024ull * 1024ull;
constexpr size_t WS_W1T = 0;
constexpr size_t WS_W2T = WS_W1T + 14 * MiB;
constexpr size_t WS_TW = WS_W2T + 4 * MiB;
constexpr size_t WS_BAR = WS_TW + 16 * 1024;
constexpr size_t WS_SGW = WS_TW + 64 * 1024;
constexpr size_t WS_KSCR = WS_W2T + 5 * MiB;
constexpr size_t WS_HYT = WS_KSCR + 32 * MiB;
constexpr size_t WS_SG = WS_HYT + 256 * MiB;
constexpr size_t WS_END = WS_SG + 192 * MiB;
constexpr int LDS_ST_OFF = FFT_LDS_CF * 8 + 1024 + 2048 * 8;
constexpr int LDS_BYTES = LDS_ST_OFF + 16;

typedef unsigned short bf16_t;
typedef short bf16x8 __attribute__((ext_vector_type(8)));
typedef float f32x4 __attribute__((ext_vector_type(4)));

struct Params {
    const float* in[22];
    float* out;
    unsigned char* ws;
};

__device__ __forceinline__ unsigned pk_bf16(float lo, float hi) { unsigned r; asm volatile("v_cvt_pk_bf16_f32 %0, %1, %2" : "=v"(r) : "v"(lo), "v"(hi)); return r; }
__device__ __forceinline__ bf16_t f2bf(float f) { return (bf16_t)(pk_bf16(f, 0.f) & 0xffffu); }
__device__ __forceinline__ float bf_lo(unsigned u) { return __uint_as_float(u << 16); }
__device__ __forceinline__ float bf_hi(unsigned u) { return __uint_as_float(u & 0xffff0000u); }
__device__ __forceinline__ float bf2f(bf16_t b) { return __uint_as_float(((unsigned)b) << 16); }
__device__ __forceinline__ float siluf(float x) { return x * __builtin_amdgcn_rcpf(1.0f + __expf(-x)); }
__device__ __forceinline__ float wave_sum(float v) {
#pragma unroll
    for (int o = 32; o >= 1; o >>= 1) v += __shfl_xor(v, o);
    return v;
}

#define XB_TMO      128
#define XB_XCNT(j)  (256  + 64 * (j))
#define XB_XSUB(j)  (1280 + 64 * (j))
#define XB_XGEN(j)  (2304 + 64 * (j))
#define XB_TOP      3328
#define XB_TOPGEN   3392
#define XCD_BAR_WORDS 3456
#define XB_SPIN_CAP (1u << 18)
#define XB_LAS __attribute__((address_space(3)))

__device__ __forceinline__ unsigned xb_ld(unsigned* p)              { return __hip_atomic_load(p, __ATOMIC_RELAXED, __HIP_MEMORY_SCOPE_AGENT); }
__device__ __forceinline__ unsigned xb_add(unsigned* p, unsigned v) { return __hip_atomic_fetch_add(p, v, __ATOMIC_RELAXED, __HIP_MEMORY_SCOPE_AGENT); }
__device__ __forceinline__ unsigned xb_xcc_id() { return (unsigned)__builtin_amdgcn_s_getreg((3 << 11) | 20) & 0xFu; }
#define XB_SPIN(cond, bar) do { unsigned _sp = 0; while (cond) { __builtin_amdgcn_s_sleep(1); \
    if ((++_sp & 255u) == 0u) { if (xb_ld(&(bar)[XB_TMO])) break; if (_sp > XB_SPIN_CAP) { atomicAdd(&(bar)[XB_TMO], 1u); break; } } } } while (0)

struct XcdBarrier {
    unsigned* bar; unsigned x;
    volatile XB_LAS unsigned* st;
};

__device__ __forceinline__ XcdBarrier xcd_barrier_post(unsigned* bar, volatile XB_LAS unsigned* st) {
    XcdBarrier b; b.bar = bar; b.x = xb_xcc_id(); b.st = st;
    if (threadIdx.x == 0) (void)xb_add(&bar[XB_XCNT(b.x)], 1u);
    return b;
}
__device__ __forceinline__ void xcd_barrier_complete(unsigned* bar, unsigned x, unsigned& nloc, unsigned& nx) {
    const unsigned G = gridDim.x * gridDim.y * gridDim.z;
    unsigned sum, cnt, mine, sp = 0u;
    for (;;) {
        sum = 0u; cnt = 0u; mine = 0u;
#pragma unroll
        for (unsigned j = 0; j < 16; ++j) { const unsigned c = xb_ld(&bar[XB_XCNT(j)]); sum += c; cnt += (c > 0u) ? 1u : 0u; mine = (j == x) ? c : mine; }
        if (sum == G) break;
        __builtin_amdgcn_s_sleep(1);
        if ((++sp & 255u) == 0u) { if (xb_ld(&bar[XB_TMO])) break; if (sp > XB_SPIN_CAP) { atomicAdd(&bar[XB_TMO], 1u); break; } }
    }
    nloc = mine > 0u ? mine : 1u; nx = cnt > 0u ? cnt : 1u;
}

__device__ __forceinline__ void xcd_barrier(const XcdBarrier& b) {
    asm volatile("s_waitcnt vmcnt(0)" ::: "memory");
    __syncthreads();
    if (threadIdx.x == 0) {
        unsigned* bar = b.bar;
        __builtin_amdgcn_s_waitcnt(0);
        unsigned nloc = b.st[0], nx = b.st[1];
        if (nloc == 0u) { xcd_barrier_complete(bar, b.x, nloc, nx); b.st[0] = nloc; b.st[1] = nx; }
        const unsigned old = xb_add(&bar[XB_XSUB(b.x)], 1u);
        const unsigned gen = old / nloc;
        if (old + 1u == (gen + 1u) * nloc) {
            __builtin_amdgcn_fence(__ATOMIC_RELEASE, "agent");
            asm volatile("s_waitcnt vmcnt(0)" ::: "memory");
            const unsigned og = xb_add(&bar[XB_TOP], 1u);
            const unsigned tg = og / nx;
            if (og + 1u == (tg + 1u) * nx) xb_add(&bar[XB_TOPGEN], 1u);
            else XB_SPIN(xb_ld(&bar[XB_TOPGEN]) == tg, bar);
            __builtin_amdgcn_fence(__ATOMIC_ACQUIRE, "agent");
            xb_add(&bar[XB_XGEN(b.x)], 1u);
            asm volatile("s_waitcnt vmcnt(0)" ::: "memory");
        } else {
            XB_SPIN(xb_ld(&bar[XB_XGEN(b.x)]) == gen, bar);
            __builtin_amdgcn_fence(__ATOMIC_ACQUIRE, "agent");
            asm volatile("s_waitcnt vmcnt(0)" ::: "memory");
        }
    }
    __syncthreads();
}

__device__ __forceinline__ int w1t_src_col(int nt) {
    if (nt < 64) return nt * 64;
    const int t = nt - 64, pn = t >> 2, sub = t & 3;
    return pn < 8 ? (sub < 2 ? 4096 + 128 * pn + 64 * sub : 6144 + 128 * pn + 64 * (sub - 2)) : 5120 + 256 * (pn - 8) + 64 * sub;
}
struct TrTile { const float* src; bf16_t* dst; };
__device__ __forceinline__ void weight_transposes(const Params& p, unsigned char* lds) {
    bf16_t* T = (bf16_t*)lds;
    bf16_t* W1T = (bf16_t*)(p.ws + WS_W1T); bf16_t* W2T = (bf16_t*)(p.ws + WS_W2T);
    const int tid = threadIdx.x, G = gridDim.x;
    const int k = tid >> 3, nc = (tid & 7) * 4;
#define TR_DESC(t, SRC, LDSRC, DST, LDDST) do { if ((t) < 1792) { const int kt = (t) & 15, nt = (t) >> 4; SRC = p.in[2] + (size_t)(kt * 64) * DIN + w1t_src_col(nt); LDSRC = DIN; DST = W1T + (size_t)(nt * 64) * DM + kt * 64; LDDST = DM; } \
        else { const int u = (t) - 1792, kt = u & 31, nt = u >> 5; SRC = p.in[20] + (size_t)(kt * 64) * DM + nt * 64; LDSRC = DM; DST = W2T + (size_t)(nt * 64) * 2048 + ((kt * 64 + 1024) & 2047); LDDST = 2048; } } while (0)
    int t = blockIdx.x;
    if (t >= 1792 + 512) return;
    const float* src; bf16_t* dst; int ldsrc, lddst;
    TR_DESC(t, src, ldsrc, dst, lddst);
    float4 a = *(const float4*)(src + (size_t)k * ldsrc + nc), b = *(const float4*)(src + (size_t)k * ldsrc + nc + 32);
    for (; t < 1792 + 512; t += G) {
        T[(nc + 0) * 72 + k] = f2bf(a.x); T[(nc + 1) * 72 + k] = f2bf(a.y); T[(nc + 2) * 72 + k] = f2bf(a.z); T[(nc + 3) * 72 + k] = f2bf(a.w);
        T[(nc + 32) * 72 + k] = f2bf(b.x); T[(nc + 33) * 72 + k] = f2bf(b.y); T[(nc + 34) * 72 + k] = f2bf(b.z); T[(nc + 35) * 72 + k] = f2bf(b.w);
        bf16_t* dcur = dst; const int ldcur = lddst;
        const int tn = t + G;
        if (tn < 1792 + 512) { TR_DESC(tn, src, ldsrc, dst, lddst); a = *(const float4*)(src + (size_t)k * ldsrc + nc); b = *(const float4*)(src + (size_t)k * ldsrc + nc + 32); }
        __syncthreads();
        { const int n = tid >> 3, kc = (tid & 7) * 8;
          const uint4 v = *(const uint4*)(T + n * 72 + kc);
          *(uint4*)(dcur + (size_t)n * ldcur + kc) = v; }
        __syncthreads();
    }
#undef TR_DESC
}

__device__ __forceinline__ void lds_barrier0() { asm volatile("s_waitcnt lgkmcnt(0)" ::: "memory"); __builtin_amdgcn_s_barrier(); asm volatile("" ::: "memory"); }
__device__ __forceinline__ void half_barrier(unsigned* ctr, unsigned& ph) {
    asm volatile("s_waitcnt lgkmcnt(0)" ::: "memory");
    ph += 4u;
    if ((threadIdx.x & 63) == 0) __hip_atomic_fetch_add(ctr, 1u, __ATOMIC_RELAXED, __HIP_MEMORY_SCOPE_WORKGROUP);
    while (__hip_atomic_load(ctr, __ATOMIC_RELAXED, __HIP_MEMORY_SCOPE_WORKGROUP) < ph) __builtin_amdgcn_s_sleep(1);
    asm volatile("" ::: "memory");
}
constexpr int FR = 32;
constexpr int FT = 256;
__device__ __forceinline__ void filter_job(const Params& p, int job, unsigned char* lds, unsigned* hctr, unsigned& hph) {
    float* WL1 = (float*)lds; float* WL2 = WL1 + 33 * 64; float* WL3 = WL2 + 64 * 64;
    float* Z = WL3 + 64 * 64;
    float* HA = Z + FR * 33 + 32;
    float* HB = HA + FR * 64;
    const int tid = threadIdx.x, t0 = job * FR;
    const float* b1 = p.in[6]; const float* f1 = p.in[7];
    const float* b2 = p.in[9]; const float* f2 = p.in[10];
    const float* b3 = p.in[12]; const float* f3 = p.in[13];
    const float* wo = p.in[14];
    float* kraw = (float*)((unsigned char*)p.out + 64 * MiB);
    for (int e = tid; e < FR * 33; e += FT) {
        const int r = e / 33, i = e % 33; const int t = t0 + r;
        const float tn = (float)t / (float)(SEQ - 1);
        float v;
        if (i == 0) v = tn;
        else {
            const int band = (i - 1) & 15;
            const float f = 1e-4f + (float)band * ((15.0f - 1e-4f) / 15.0f);
            const float a2 = 2.0f * f * ((float)t / (float)SEQ);
            v = (i <= 16) ? cospif(a2) : -sinpif(a2);
        }
        Z[r * 33 + i] = v;
    }
    half_barrier(hctr, hph);
#pragma unroll 2
    for (int it = 0; it < FR * 64 / FT; ++it) {
        const int e = tid + it * FT, r = e >> 6, j = e & 63; float s = b1[j];
#pragma unroll 11
        for (int i = 0; i < 33; ++i) s += Z[r * 33 + i] * WL1[i * 64 + j];
        HA[r * 64 + j] = sinpif(f1[j] * s * 0.31830988618379067f);
    }
    half_barrier(hctr, hph);
#pragma unroll 2
    for (int it = 0; it < FR * 64 / FT; ++it) {
        const int e = tid + it * FT, r = e >> 6, j = e & 63; float s = b2[j];
#pragma unroll 16
        for (int i = 0; i < 64; ++i) s += HA[r * 64 + i] * WL2[i * 64 + j];
        HB[r * 64 + j] = sinpif(f2[j] * s * 0.31830988618379067f);
    }
    half_barrier(hctr, hph);
#pragma unroll 2
    for (int it = 0; it < FR * 64 / FT; ++it) {
        const int e = tid + it * FT, r = e >> 6, j = e & 63; float s = b3[j];
#pragma unroll 16
        for (int i = 0; i < 64; ++i) s += HB[r * 64 + i] * WL3[i * 64 + j];
        HA[r * 64 + j] = sinpif(f3[j] * s * 0.31830988618379067f);
    }
    half_barrier(hctr, hph);
    const float da = -3.0701134573253945f, db = -15.350567286626973f;
    typedef float f32x16 __attribute__((ext_vector_type(16)));
    const int lane = tid & 63, wave = tid >> 6, l31 = lane & 31, lh = lane >> 5;
    float af[32];
#pragma unroll
    for (int i = 0; i < 32; ++i) af[i] = HA[l31 * 64 + 2 * i + lh];
#pragma unroll 1
    for (int tile = 0; tile < 16; ++tile) {
        const int n = wave * 512 + tile * 32 + l31;
        float bv[32];
#pragma unroll
        for (int i = 0; i < 32; ++i) bv[i] = wo[(2 * i + lh) * 2048 + n];
        f32x16 acc;
#pragma unroll
        for (int i = 0; i < 16; ++i) acc[i] = 0.f;
#pragma unroll
        for (int i = 0; i < 32; ++i) acc = __builtin_amdgcn_mfma_f32_32x32x2f32(af[i], bv[i], acc, 0, 0, 0);
        const int cl = n & 1023;
        const float delta = fabsf(da + (db - da) * ((float)cl / 1023.0f));
        float* ST = (float*)(lds + 65536) + wave * (32 * 36);
#pragma unroll
        for (int i4 = 0; i4 < 4; ++i4) {
            const int tb = 8 * i4 + 4 * lh; float4 v;
            v.x = acc[4 * i4 + 0] * __expf(-((float)(t0 + tb + 0) / (float)(SEQ - 1)) * delta); v.y = acc[4 * i4 + 1] * __expf(-((float)(t0 + tb + 1) / (float)(SEQ - 1)) * delta);
            v.z = acc[4 * i4 + 2] * __expf(-((float)(t0 + tb + 2) / (float)(SEQ - 1)) * delta); v.w = acc[4 * i4 + 3] * __expf(-((float)(t0 + tb + 3) / (float)(SEQ - 1)) * delta);
            *(float4*)(ST + l31 * 36 + tb) = v;
        }
        const int nb = wave * 512 + tile * 32, half = nb >> 10, cb0 = nb & 1023;
#pragma unroll
        for (int ps = 0; ps < 4; ++ps) {
            const int rowi = ps * 8 + (lane >> 3), ch4 = (lane & 7) * 4, c = cb0 + rowi;
            const float4 v = *(const float4*)(ST + rowi * 36 + ch4);
            *(float4*)(kraw + (size_t)c * FFT_N + ((half * SEQ + t0 + ch4 + 64 * c) & (FFT_N - 1))) = v;
        }
    }
}

__device__ __forceinline__ void phase0(const Params& p, unsigned char* lds, int parts) {
    const int tid = threadIdx.x, lane = tid & 63, wave = tid >> 6, G = gridDim.x, bid = blockIdx.x;
    if (parts & 1) {
        unsigned* hctr = (unsigned*)(lds + LDS_ST_OFF) + 2;
        if (wave < 4) {
            if (bid < SEQ / FR) {
                unsigned hph = 0u;
                float* WL = (float*)lds;
                for (int i = tid; i < 33 * 64; i += FT) WL[i] = p.in[5][i];
                for (int i = tid; i < 64 * 64; i += FT) { WL[33 * 64 + i] = p.in[8][i]; WL[33 * 64 + 64 * 64 + i] = p.in[11][i]; }
                half_barrier(hctr, hph);
                for (int job = bid; job < SEQ / FR; job += G) { filter_job(p, job, lds, hctr, hph); half_barrier(hctr, hph); }
            }
        } else {
            bf16_t* hn = (bf16_t*)p.out; const float* x = p.in[0]; const float* w = p.in[1];
            int row = bid * 4 + (wave - 4); float4 nx[4], nx2[4];
#pragma unroll
            for (int i = 0; i < 4; ++i) nx[i] = *(const float4*)(x + (size_t)row * DM + i * 256 + lane * 4);
            if (row + G * 4 < MTOK) {
#pragma unroll
                for (int i = 0; i < 4; ++i) nx2[i] = *(const float4*)(x + (size_t)(row + G * 4) * DM + i * 256 + lane * 4);
            }
            for (; row < MTOK; row += G * 4) {
                float4 v[4]; float ss = 0.f;
#pragma unroll
                for (int i = 0; i < 4; ++i) { v[i] = nx[i]; nx[i] = nx2[i]; }
                const int rn = row + G * 8;
                if (rn < MTOK) {
#pragma unroll
                    for (int i = 0; i < 4; ++i) nx2[i] = *(const float4*)(x + (size_t)rn * DM + i * 256 + lane * 4);
                }
#pragma unroll
                for (int i = 0; i < 4; ++i) ss += v[i].x * v[i].x + v[i].y * v[i].y + v[i].z * v[i].z + v[i].w * v[i].w;
                ss = wave_sum(ss);
                const float r = rsqrtf(ss * (1.0f / DM) + EPSF);
#pragma unroll
                for (int i = 0; i < 4; ++i) { const float4 ww = *(const float4*)(w + i * 256 + lane * 4);
                    uint2 o; o.x = pk_bf16(v[i].x * r * ww.x, v[i].y * r * ww.y); o.y = pk_bf16(v[i].z * r * ww.z, v[i].w * r * ww.w);
                    *(uint2*)(hn + (size_t)row * DM + i * 256 + lane * 4) = o; }
            }
        }
        __syncthreads();
        if (tid == 0) *hctr = 0u;
        __syncthreads();
    }
    if (parts & 2) weight_transposes(p, lds);
    if (parts & 2) { bf16_t* sgw = (bf16_t*)(p.ws + WS_SGW); const float* s = p.in[18];
      for (int i = bid * NT + tid; i < 8 * 128 * 128; i += G * NT) sgw[i] = f2bf(s[i]);
      cf* tw = (cf*)(p.ws + WS_TW);
      for (int i = bid * NT + tid; i < 2048; i += G * NT) { float sn, cs; sincospif(-2.0f * (float)i / (float)FFT_N, &sn, &cs); tw[i] = cf{cs, sn}; } }
}

struct EpiHyT {
    static constexpr bool PERM = false, AFTER_DRAIN = false, SWAP = true;
    bf16_t* O;
    unsigned char* st;
    __device__ __forceinline__ void operator()(const pg8::f32x4 (&acc)[2][2][4][2], const pg8::Unit& u, int wr, int wc, int fr, int fq) const {
        const int lane = fq * 16 + fr;
        unsigned char* S = st + (wr * 4 + wc) * 2304;
        const int row0 = u.pm * 256 + wr * 64, b = row0 >> 13, tb = row0 & (SEQ - 1);
        const int rrow = lane >> 3, rchk = lane & 7;
#pragma unroll
        for (int ai = 0; ai < 2; ++ai)
#pragma unroll
            for (int bj = 0; bj < 2; ++bj)
#pragma unroll
                for (int n = 0; n < 2; ++n) {
#pragma unroll
                    for (int m = 0; m < 4; ++m) { const pg8::f32x4 v = acc[ai][bj][m][n]; uint2 o; o.x = pk_bf16(v[0], v[1]); o.y = pk_bf16(v[2], v[3]);
                        *(uint2*)(S + fr * 144 + (16 * m + 4 * fq) * 2) = o; }
#pragma unroll
                    for (int ps = 0; ps < 2; ++ps) { const int r = ps * 8 + rrow; const uint4 v = *(const uint4*)(S + r * 144 + rchk * 16);
                        const int ch = u.pn * 256 + bj * 128 + wc * 32 + n * 16 + r;
                        *(uint4*)(O + ((size_t)b * NHY + ch) * SEQ + tb + ai * 128 + rchk * 8) = v; }
                }
    }
};

struct EpiSg {
    static constexpr bool PERM = true, AFTER_DRAIN = false, SWAP = false;
    bf16_t* O;
    __device__ __forceinline__ void operator()(const pg8::f32x4 (&acc)[2][2][4][2], const pg8::Unit& u, int wr, int wc, int fr, int fq) const {
        const int row0 = u.pm * 256 + wr * 64 + fr;
        if (u.pn < 8) {
            const int col0 = u.pn * 128 + wc * 32 + 8 * fq;
#pragma unroll
            for (int ai = 0; ai < 2; ++ai)
#pragma unroll
                for (int m = 0; m < 4; ++m) { bf16_t* rowp = O + (size_t)(row0 + ai * 128 + m * 16) * NSG + col0;
                    const pg8::f32x4 u0 = acc[ai][0][m][0], u1 = acc[ai][0][m][1], g0 = acc[ai][1][m][0], g1 = acc[ai][1][m][1];
                    uint4 w; w.x = pk_bf16(u0[0] * siluf(g0[0]), u0[1] * siluf(g0[1])); w.y = pk_bf16(u0[2] * siluf(g0[2]), u0[3] * siluf(g0[3]));
                    w.z = pk_bf16(u1[0] * siluf(g1[0]), u1[1] * siluf(g1[1])); w.w = pk_bf16(u1[2] * siluf(g1[2]), u1[3] * siluf(g1[3]));
                    *(uint4*)rowp = w; }
        } else {
            const int col0 = 1024 + (u.pn - 8) * 256 + wc * 32 + 8 * fq;
#pragma unroll
            for (int ai = 0; ai < 2; ++ai)
#pragma unroll
                for (int m = 0; m < 4; ++m) { bf16_t* rowp = O + (size_t)(row0 + ai * 128 + m * 16) * NSG + col0;
#pragma unroll
                    for (int bj = 0; bj < 2; ++bj) { const pg8::f32x4 v0 = acc[ai][bj][m][0], v1 = acc[ai][bj][m][1];
                        uint4 w; w.x = pk_bf16(v0[0], v0[1]); w.y = pk_bf16(v0[2], v0[3]); w.z = pk_bf16(v1[0], v1[1]); w.w = pk_bf16(v1[2], v1[3]);
                        *(uint4*)(rowp + bj * 128) = w; } }
        }
    }
};

__device__ __forceinline__ void lds_barrier() { asm volatile("s_waitcnt lgkmcnt(0)" ::: "memory"); __builtin_amdgcn_s_barrier(); asm volatile("" ::: "memory"); }
template <int MODE>
__device__ __forceinline__ void fft_fwd3(cf* X, const cf* tw, int tid) {
    fft_stage<32, false, 512, 1, MODE>(X, tw, tid, NT); lds_barrier();
    fft_stage<32, false, 16, 32>(X, tw, tid, NT); lds_barrier();
}
__device__ __forceinline__ void fft_inv3(cf* X, const cf* tw, int tid) {
    fft_stage<32, true, 16, 32>(X, tw, tid, NT); lds_barrier();
    fft_stage<32, true, 512, 1, 2>(X, tw, tid, NT); lds_barrier();
}
struct Raw8 { uint4 q; bf16_t lo, hi; };
__device__ __forceinline__ Raw8 load_raw8(const bf16_t* row, int t0) {
    const int lane = threadIdx.x & 63;
    Raw8 r; r.q = *(const uint4*)(row + t0); r.lo = (bf16_t)0; r.hi = (bf16_t)0;
    if (lane == 0 && t0 > 0) r.lo = row[t0 - 1];
    if (lane == 63 && t0 + 8 < SEQ) r.hi = row[t0 + 8];
    return r;
}
__device__ __forceinline__ void conv8r(const Raw8& r, float w0, float w1, float w2, float bias, float (&o)[8]) {
    const int lane = threadIdx.x & 63;
    const unsigned prev = __shfl_up(r.q.w >> 16, 1), next = __shfl_down(r.q.x & 0xffffu, 1);
    float v[10];
    v[0] = __uint_as_float((lane == 0 ? (unsigned)r.lo : prev) << 16);
    v[1] = bf_lo(r.q.x); v[2] = bf_hi(r.q.x); v[3] = bf_lo(r.q.y); v[4] = bf_hi(r.q.y); v[5] = bf_lo(r.q.z); v[6] = bf_hi(r.q.z); v[7] = bf_lo(r.q.w); v[8] = bf_hi(r.q.w);
    v[9] = __uint_as_float((lane == 63 ? (unsigned)r.hi : next) << 16);
#pragma unroll
    for (int j = 0; j < 8; ++j) o[j] = v[j] * w0 + v[j + 1] * w1 + v[j + 2] * w2 + bias;
}
struct RawU { Raw8 v0[2], x0[2], v1[2], x1[2]; };
__device__ __forceinline__ void hyena_job(const Params& p, int c, unsigned char* lds, bool dry = false) {
    cf* X = (cf*)lds; float* red = (float*)(lds + FFT_LDS_CF * 8);
    const int tid = threadIdx.x, lane = tid & 63, wave = tid >> 6;
    const cf* tw = (const cf*)(lds + FFT_LDS_CF * 8 + 1024);
    bf16_t* HYT = (bf16_t*)(p.ws + WS_HYT);
    const float* cw = p.in[3]; const float* cb = p.in[4];
    float4* ks = (float4*)(p.ws + WS_KSCR) + (size_t)blockIdx.x * (FFT_N / 2);
    RawU ru;
#define LOAD_RU(PAIR) do { const bf16_t* _v0 = HYT + ((size_t)(2 * (PAIR)) * NHY + 2048 + c) * SEQ; const bf16_t* _v1 = _v0 + (size_t)NHY * SEQ; \
        const bf16_t* _x0 = HYT + ((size_t)(2 * (PAIR)) * NHY + 1024 + c) * SEQ; const bf16_t* _x1 = _x0 + (size_t)NHY * SEQ; \
        _Pragma("unroll") for (int it = 0; it < 2; ++it) { const int t0 = (tid + it * NT) * 8; \
            ru.v0[it] = load_raw8(_v0, t0); ru.x0[it] = load_raw8(_x0, t0); ru.v1[it] = load_raw8(_v1, t0); ru.x1[it] = load_raw8(_x1, t0); } } while (0)
    LOAD_RU(0);
    { const float* kr = (const float*)((const unsigned char*)p.out + 64 * MiB) + (size_t)c * FFT_N;
      float4 kv[8];
#pragma unroll
      for (int it = 0; it < 8; ++it) kv[it] = *(const float4*)(kr + ((tid * 4 + it * (NT * 4) + 64 * c) & (FFT_N - 1)));
      float l1 = 0.f;
#pragma unroll
      for (int it = 0; it < 8; ++it) { const float4 v = kv[it]; const int i = tid * 4 + it * (NT * 4);
          if (it < 4) {
              l1 += fabsf(v.x) + fabsf(v.y) + fabsf(v.z) + fabsf(v.w);
              const int pi = PADI(i); X[pi] = cf{v.x, 0.f}; X[pi + 1] = cf{v.y, 0.f}; X[pi + 2] = cf{v.z, 0.f}; X[pi + 3] = cf{v.w, 0.f};
          } else {
              const int m = i - SEQ;
              l1 += (m == 0 ? 0.f : fabsf(v.x)) + fabsf(v.y) + fabsf(v.z) + fabsf(v.w);
              X[PADI(m == 0 ? SEQ : FFT_N - m)] = cf{m == 0 ? 0.f : v.x, 0.f};
              const int pb = PADI(FFT_N - m - 3); X[pb + 2] = cf{v.y, 0.f}; X[pb + 1] = cf{v.z, 0.f}; X[pb] = cf{v.w, 0.f};
          } }
      l1 = wave_sum(l1); if (lane == 0) red[wave] = l1;
      lds_barrier();
      float tot = 0.f;
#pragma unroll
      for (int i = 0; i < 8; ++i) tot += red[i];
      fft_fwd3<0>(X, tw, tid);
      const float sc = 1.0f / ((tot + EPSF) * (float)FFT_N), sk = p.in[15][c] * (1.0f / (float)FFT_N);
#pragma unroll 1
      for (int g = tid; g < FFT_N / 16; g += NT) {
          const int pb = PADI(g * 16); cf a[16];
#pragma unroll
          for (int j = 0; j < 16; ++j) a[j] = X[pb + j];
          dft16<false>(a);
#pragma unroll
          for (int j = 0; j < 16; j += 2) (ks + (j >> 1) * (FFT_N / 16))[(unsigned)g] = make_float4(a[j].x * sc + sk, a[j].y * sc, a[j + 1].x * sc + sk, a[j + 1].y * sc);
      }
      asm volatile("s_waitcnt vmcnt(0)" ::: "memory");
      __syncthreads();
      if (wave == 0) {
          __builtin_amdgcn_fence(__ATOMIC_ACQUIRE, "agent");
          asm volatile("s_waitcnt vmcnt(0)" ::: "memory");
      }
      __syncthreads();
    }
    const float x0w0 = cw[c], x0w1 = cw[3072 + c], x0w2 = cw[6144 + c], x0b = cb[c];
    const float x1w0 = cw[1024 + c], x1w1 = cw[3072 + 1024 + c], x1w2 = cw[6144 + 1024 + c], x1b = cb[1024 + c];
    const float vw0 = cw[2048 + c], vw1 = cw[3072 + 2048 + c], vw2 = cw[6144 + 2048 + c], vb = cb[2048 + c];
#pragma unroll
    for (int pair = 0; pair < 2; ++pair) {
        const int b0 = 2 * pair, b1 = b0 + 1;
        bf16_t* vr0 = HYT + ((size_t)b0 * NHY + 2048 + c) * SEQ; bf16_t* vr1 = HYT + ((size_t)b1 * NHY + 2048 + c) * SEQ;
        bf16_t* yo0 = dry ? (bf16_t*)p.out + ((size_t)b0 * 1024 + c) * SEQ : vr0; bf16_t* yo1 = dry ? (bf16_t*)p.out + ((size_t)b1 * 1024 + c) * SEQ : vr1;
        {
#pragma unroll
            for (int it = 0; it < 2; ++it) { const int t0 = (tid + it * NT) * 8; float a[8], b[8], u0[8], u1[8];
                conv8r(ru.v0[it], vw0, vw1, vw2, vb, a); conv8r(ru.x0[it], x1w0, x1w1, x1w2, x1b, b);
#pragma unroll
                for (int j = 0; j < 8; ++j) u0[j] = a[j] * b[j];
                conv8r(ru.v1[it], vw0, vw1, vw2, vb, a); conv8r(ru.x1[it], x1w0, x1w1, x1w2, x1b, b);
#pragma unroll
                for (int j = 0; j < 8; ++j) u1[j] = a[j] * b[j];
                const int pi = PADI(t0);
#pragma unroll
                for (int j = 0; j < 8; ++j) X[pi + j] = cf{u0[j], u1[j]}; }
        }
        lds_barrier();
        fft_fwd3<1>(X, tw, tid);
        {
#pragma unroll 1
            for (int h = 0; h < 2; ++h) {
                const unsigned g = (unsigned)(tid + h * NT);
                float4 kk[8];
#pragma unroll
                for (int q = 0; q < 8; ++q) kk[q] = (ks + q * (FFT_N / 16))[g];
                const int pb = PADI((int)g * 16); cf a[16], b[16];
#pragma unroll
                for (int j = 0; j < 16; ++j) a[j] = X[pb + j];
                dft16<false>(a);
#pragma unroll
                for (int j = 0; j < 16; ++j) { const float4 k4 = kk[j >> 1]; const cf k = (j & 1) ? cf{k4.z, k4.w} : cf{k4.x, k4.y}; b[KIDX<16>(j)] = cmul(a[j], k); }
                dft16<true>(b);
#pragma unroll
                for (int j = 0; j < 16; ++j) X[pb + KIDX<16>(j)] = b[j];
            }
        }
        const bf16_t* x0r0 = HYT + ((size_t)b0 * NHY + c) * SEQ; const bf16_t* x0r1 = HYT + ((size_t)b1 * NHY + c) * SEQ;
        const bf16_t* gr0 = HYT + ((size_t)b0 * NHY + 3072 + c) * SEQ; const bf16_t* gr1 = HYT + ((size_t)b1 * NHY + 3072 + c) * SEQ;
        Raw8 r0[2], r1[2]; uint4 g0[2], g1[2];
#pragma unroll
        for (int it = 0; it < 2; ++it) { const int t0 = (tid + it * NT) * 8;
            r0[it] = load_raw8(x0r0, t0); r1[it] = load_raw8(x0r1, t0); g0[it] = *(const uint4*)(gr0 + t0); g1[it] = *(const uint4*)(gr1 + t0); }
        lds_barrier();
        fft_inv3(X, tw, tid);
        if (pair == 0) LOAD_RU(1);
        {
#pragma unroll
            for (int it = 0; it < 2; ++it) { const int t0 = (tid + it * NT) * 8, pi = PADI(t0); float a[8], y[8];
                { conv8r(r0[it], x0w0, x0w1, x0w2, x0b, a); const uint4 g = g0[it];
                  const float gg[8] = {bf_lo(g.x), bf_hi(g.x), bf_lo(g.y), bf_hi(g.y), bf_lo(g.z), bf_hi(g.z), bf_lo(g.w), bf_hi(g.w)};
#pragma unroll
                  for (int j = 0; j < 8; ++j) y[j] = a[j] * X[pi + j].x * siluf(gg[j]);
                  uint4 o; o.x = pk_bf16(y[0], y[1]); o.y = pk_bf16(y[2], y[3]); o.z = pk_bf16(y[4], y[5]); o.w = pk_bf16(y[6], y[7]);
                  *(uint4*)(yo0 + t0) = o; }
                { conv8r(r1[it], x0w0, x0w1, x0w2, x0b, a); const uint4 g = g1[it];
                  const float gg[8] = {bf_lo(g.x), bf_hi(g.x), bf_lo(g.y), bf_hi(g.y), bf_lo(g.z), bf_hi(g.z), bf_lo(g.w), bf_hi(g.w)};
#pragma unroll
                  for (int j = 0; j < 8; ++j) y[j] = a[j] * X[pi + j].y * siluf(gg[j]);
                  uint4 o; o.x = pk_bf16(y[0], y[1]); o.y = pk_bf16(y[2], y[3]); o.z = pk_bf16(y[4], y[5]); o.w = pk_bf16(y[6], y[7]);
                  *(uint4*)(yo1 + t0) = o; } }
        }
        lds_barrier();
    }
}

#undef LOAD_RU
__device__ __forceinline__ uint4 gmlp_group(const bf16_t* vnT, const bf16x8 (&wf)[4], int g, int fr, int fq, float bias, uint4 u4) {
    constexpr int PITCH = 136;
    f32x4 acc0 = (f32x4){0.f, 0.f, 0.f, 0.f}, acc1 = (f32x4){0.f, 0.f, 0.f, 0.f};
    const int drow = 32 * g + 8 * (fr >> 2) + (fr & 3);
#pragma unroll
    for (int ks = 0; ks < 4; ++ks) { const int kq = (ks * 32 + fq * 8) ^ ((fr >> 2) << 4);
        const bf16x8 v0 = *(const bf16x8*)(vnT + drow * PITCH + kq), v1 = *(const bf16x8*)(vnT + (drow + 4) * PITCH + kq);
        acc0 = __builtin_amdgcn_mfma_f32_16x16x32_bf16(v0, wf[ks], acc0, 0, 0, 0); acc1 = __builtin_amdgcn_mfma_f32_16x16x32_bf16(v1, wf[ks], acc1, 0, 0, 0); }
    const float y0 = bf_lo(u4.x) * (acc0[0] + bias), y1 = bf_hi(u4.x) * (acc0[1] + bias), y2 = bf_lo(u4.y) * (acc0[2] + bias), y3 = bf_hi(u4.y) * (acc0[3] + bias);
    const float y4 = bf_lo(u4.z) * (acc1[0] + bias), y5 = bf_hi(u4.z) * (acc1[1] + bias), y6 = bf_lo(u4.w) * (acc1[2] + bias), y7 = bf_hi(u4.w) * (acc1[3] + bias);
    uint4 o; o.x = pk_bf16(y0, y1); o.y = pk_bf16(y2, y3); o.z = pk_bf16(y4, y5); o.w = pk_bf16(y6, y7);
    return o;
}
__device__ __forceinline__ uint4 swap8(uint4 v) {
    uint4 r; r.x = (unsigned)__shfl_xor((int)v.x, 8); r.y = (unsigned)__shfl_xor((int)v.y, 8); r.z = (unsigned)__shfl_xor((int)v.z, 8); r.w = (unsigned)__shfl_xor((int)v.w, 8); return r;
}
__device__ __forceinline__ uint4 sel4(bool c, uint4 a, uint4 b) { uint4 r; r.x = c ? a.x : b.x; r.y = c ? a.y : b.y; r.z = c ? a.z : b.z; r.w = c ? a.w : b.w; return r; }
__device__ __forceinline__ void gmlp_phase(const Params& p, unsigned char* lds, bool dry, int k0 = 0, int nk = 1 << 20) {
    constexpr int PITCH = 136;
    bf16_t* SG = (bf16_t*)(p.ws + WS_SG);
    const bf16_t* sgw = (const bf16_t*)(p.ws + WS_SGW);
    const int tid = threadIdx.x, lane = tid & 63, wave = tid >> 6, G = gridDim.x;
    const int q = tid >> 2, part = tid & 3;
    const int qs = q ^ (part << 4);
    const int fr = lane & 15, fq = lane >> 4, p0 = wave * 16;
    int j = blockIdx.x + G * k0;
    const int jmax = min(2048, (int)blockIdx.x + (nk >= (1 << 20) ? (1 << 24) : G * (k0 + nk)));
    if (j >= jmax) return;
    uint4 vq[4];
    { const bf16_t* src = SG + ((size_t)(j >> 3) * 128 + q) * NSG + 1024 + (j & 7) * 128 + part * 8;
#pragma unroll
      for (int i = 0; i < 4; ++i) vq[i] = *(const uint4*)(src + i * 32); }
    int buf = 0;
#pragma unroll 1
    for (; j < jmax; j += G, buf ^= 1) {
        const int chunk = j >> 3, h = j & 7;
        const size_t t0 = (size_t)chunk * 128;
        bf16_t* vnT = (bf16_t*)(lds + buf * (128 * PITCH * 2));
        uint4 la[2], lb[2]; bf16x8 wf[4];
        const int r7 = fr & 7, hi = fr >> 3;
        const size_t rowA = (t0 + p0 + r7) * NSG, rowB = rowA + 8 * (size_t)NSG;
#pragma unroll
        for (int gp = 0; gp < 2; ++gp) { const int d = h * 128 + 32 * (2 * gp + hi) + 8 * fq; la[gp] = *(const uint4*)(SG + rowA + d); lb[gp] = *(const uint4*)(SG + rowB + d); }
#pragma unroll
        for (int ks = 0; ks < 4; ++ks) wf[ks] = *(const bf16x8*)(sgw + ((size_t)h * 128 + p0 + fr) * 128 + ks * 32 + fq * 8);
        const float bias = p.in[19][h * 128 + p0 + fr];
        {
            float v[32];
#pragma unroll
            for (int i = 0; i < 4; ++i) { const uint4 w = vq[i];
                v[8 * i + 0] = bf_lo(w.x); v[8 * i + 1] = bf_hi(w.x); v[8 * i + 2] = bf_lo(w.y); v[8 * i + 3] = bf_hi(w.y);
                v[8 * i + 4] = bf_lo(w.z); v[8 * i + 5] = bf_hi(w.z); v[8 * i + 6] = bf_lo(w.w); v[8 * i + 7] = bf_hi(w.w); }
            const int jn = j + G;
            if (jn < jmax) { const bf16_t* src = SG + ((size_t)(jn >> 3) * 128 + q) * NSG + 1024 + (jn & 7) * 128 + part * 8;
#pragma unroll
                for (int i = 0; i < 4; ++i) vq[i] = *(const uint4*)(src + i * 32); }
            float s = 0.f;
#pragma unroll
            for (int i = 0; i < 32; ++i) s += v[i];
            s += __shfl_xor(s, 1); s += __shfl_xor(s, 2);
            const float mu = s * (1.0f / 128.0f);
            float qq = 0.f;
#pragma unroll
            for (int i = 0; i < 32; ++i) { const float d = v[i] - mu; qq += d * d; }
            qq += __shfl_xor(qq, 1); qq += __shfl_xor(qq, 2);
            const float rstd = rsqrtf(qq * (1.0f / 128.0f) + EPSF);
            const float* nw = p.in[16] + h * 128 + part * 8; const float* nb = p.in[17] + h * 128 + part * 8;
#pragma unroll
            for (int i = 0; i < 32; i += 4) { const int dd = 32 * (i >> 3) + (i & 7); const float4 w4 = *(const float4*)(nw + dd), b4 = *(const float4*)(nb + dd);
                vnT[(part * 8 + dd + 0) * PITCH + qs] = f2bf((v[i + 0] - mu) * rstd * w4.x + b4.x); vnT[(part * 8 + dd + 1) * PITCH + qs] = f2bf((v[i + 1] - mu) * rstd * w4.y + b4.y);
                vnT[(part * 8 + dd + 2) * PITCH + qs] = f2bf((v[i + 2] - mu) * rstd * w4.z + b4.z); vnT[(part * 8 + dd + 3) * PITCH + qs] = f2bf((v[i + 3] - mu) * rstd * w4.w + b4.w); }
        }
        lds_barrier();
#pragma unroll
        for (int gp = 0; gp < 2; ++gp) {
            const bool hb = hi != 0;
            const uint4 rcv = swap8(sel4(hb, la[gp], lb[gp]));
            const uint4 u0 = sel4(hb, rcv, la[gp]), u1 = sel4(hb, lb[gp], rcv);
            const uint4 yo0 = gmlp_group(vnT, wf, 2 * gp, fr, fq, bias, u0), yo1 = gmlp_group(vnT, wf, 2 * gp + 1, fr, fq, bias, u1);
            const uint4 rcv2 = swap8(sel4(hb, yo0, yo1));
            const uint4 oa = sel4(hb, rcv2, yo0), ob = sel4(hb, yo1, rcv2);
            const int d = h * 128 + 32 * (2 * gp + hi) + 8 * fq;
            if (dry) { *(uint4*)((bf16_t*)p.out + (t0 + p0 + r7) * 1024 + d) = oa; *(uint4*)((bf16_t*)p.out + (t0 + p0 + 8 + r7) * 1024 + d) = ob; }
            else { *(uint4*)(SG + rowA + d) = oa; *(uint4*)(SG + rowB + d) = ob; }
        }
    }
    __syncthreads();
}

__device__ __forceinline__ void ya_transpose_phase(const Params& p, unsigned char* lds) {
    const bf16_t* HYT = (const bf16_t*)(p.ws + WS_HYT); bf16_t* SG = (bf16_t*)(p.ws + WS_SG);
    const int tid = threadIdx.x, G = gridDim.x;
    const int c = tid >> 3, tc = (tid & 7) * 8;
    int tile = blockIdx.x, buf = 0;
    if (tile >= 8192) return;
#define YA_SRC(t) (HYT + ((size_t)((t) >> 11) * NHY + 2048 + (((t) >> 7) & 15) * 64 + c) * SEQ + ((t) & 127) * 64 + tc)
    uint4 v = *(const uint4*)YA_SRC(tile);
    for (; tile < 8192; tile += G, buf ^= 1) {
        bf16_t* T = (bf16_t*)lds + buf * (64 * 72);
        T[(tc + 0) * 72 + c] = (bf16_t)(v.x & 0xffff); T[(tc + 1) * 72 + c] = (bf16_t)(v.x >> 16); T[(tc + 2) * 72 + c] = (bf16_t)(v.y & 0xffff); T[(tc + 3) * 72 + c] = (bf16_t)(v.y >> 16);
        T[(tc + 4) * 72 + c] = (bf16_t)(v.z & 0xffff); T[(tc + 5) * 72 + c] = (bf16_t)(v.z >> 16); T[(tc + 6) * 72 + c] = (bf16_t)(v.w & 0xffff); T[(tc + 7) * 72 + c] = (bf16_t)(v.w >> 16);
        const int tn = tile + G;
        if (tn < 8192) v = *(const uint4*)YA_SRC(tn);
        lds_barrier();
        const int tt = tile & 127, ct = (tile >> 7) & 15, b = tile >> 11;
        { const int t = tid >> 3, cc = (tid & 7) * 8;
          const uint4 o = *(const uint4*)(T + t * 72 + cc);
          *(uint4*)(SG + ((size_t)b * SEQ + tt * 64 + t) * NSG + 1024 + ct * 64 + cc) = o; }
    }
#undef YA_SRC
    lds_barrier();
}

__device__ __forceinline__ void phase5(const Params& p) {
    const int tid = threadIdx.x, lane = tid & 63, wave = tid >> 6, G = gridDim.x, bid = blockIdx.x;
    const float* x = p.in[0]; const float* w = p.in[21]; float* out = p.out;
    const bf16_t* Y = (const bf16_t*)(p.ws + WS_HYT);
    float4 ww[4];
#pragma unroll
    for (int i = 0; i < 2; ++i)
#pragma unroll
        for (int hh = 0; hh < 2; ++hh) ww[i * 2 + hh] = *(const float4*)(w + i * 512 + lane * 8 + hh * 4);
    int row = bid * 8 + wave;
    uint4 nq[2]; float4 nxx[4];
#pragma unroll
    for (int i = 0; i < 2; ++i) { nq[i] = *(const uint4*)(Y + (size_t)row * DM + i * 512 + lane * 8);
#pragma unroll
        for (int hh = 0; hh < 2; ++hh) nxx[i * 2 + hh] = *(const float4*)(x + (size_t)row * DM + i * 512 + lane * 8 + hh * 4); }
    for (; row < MTOK; row += G * 8) {
        float* orow = out + (size_t)row * DM;
        uint4 q[2]; float4 xx[4]; float v[2][8]; float ss = 0.f;
#pragma unroll
        for (int i = 0; i < 2; ++i) q[i] = nq[i];
#pragma unroll
        for (int i = 0; i < 4; ++i) xx[i] = nxx[i];
        const int rn = row + G * 8;
        if (rn < MTOK) {
#pragma unroll
            for (int i = 0; i < 2; ++i) { nq[i] = *(const uint4*)(Y + (size_t)rn * DM + i * 512 + lane * 8);
#pragma unroll
                for (int hh = 0; hh < 2; ++hh) nxx[i * 2 + hh] = *(const float4*)(x + (size_t)rn * DM + i * 512 + lane * 8 + hh * 4); }
        }
#pragma unroll
        for (int i = 0; i < 2; ++i) { v[i][0] = bf_lo(q[i].x); v[i][1] = bf_hi(q[i].x); v[i][2] = bf_lo(q[i].y); v[i][3] = bf_hi(q[i].y);
            v[i][4] = bf_lo(q[i].z); v[i][5] = bf_hi(q[i].z); v[i][6] = bf_lo(q[i].w); v[i][7] = bf_hi(q[i].w);
#pragma unroll
            for (int j = 0; j < 8; ++j) ss += v[i][j] * v[i][j]; }
        ss = wave_sum(ss);
        const float r = rsqrtf(ss * (1.0f / DM) + EPSF);
#pragma unroll
        for (int i = 0; i < 2; ++i)
#pragma unroll
            for (int hh = 0; hh < 2; ++hh) { const int col = i * 512 + lane * 8 + hh * 4; const float4 wq = ww[i * 2 + hh], xq = xx[i * 2 + hh];
                float4 o; o.x = xq.x + v[i][hh * 4 + 0] * r * wq.x; o.y = xq.y + v[i][hh * 4 + 1] * r * wq.y; o.z = xq.z + v[i][hh * 4 + 2] * r * wq.z; o.w = xq.w + v[i][hh * 4 + 3] * r * wq.w;
                *(float4*)(orow + col) = o; }
    }
}

__global__ void __launch_bounds__(NT, 2) hyena_gmlp_fwd(Params p) {
    extern __shared__ __attribute__((aligned(16))) unsigned char lds[];
    cg::grid_group grid = cg::this_grid();
    const int G = gridDim.x, bid = blockIdx.x;
    PG8_LAS unsigned char* ldsl = (PG8_LAS unsigned char*)lds;
    if (threadIdx.x < 4) ((unsigned*)(lds + LDS_ST_OFF))[threadIdx.x] = 0u;
    __syncthreads();
    if (bid == 0) { unsigned* bw = (unsigned*)(p.ws + WS_BAR); for (int i = threadIdx.x; i < XCD_BAR_WORDS; i += NT) bw[i] = 0u; }

    phase0(p, lds, 7);
#if PROBE_REP == 21
    phase0(p, lds, 1);
#elif PROBE_REP == 22
    phase0(p, lds, 2);
#elif PROBE_REP == 23
    phase0(p, lds, 4);
#elif PROBE_REP == 1
    phase0(p, lds, 7);
#endif
    grid.sync();
    const XcdBarrier xbar = xcd_barrier_post((unsigned*)(p.ws + WS_BAR), (volatile XB_LAS unsigned*)(lds + LDS_ST_OFF));

#pragma unroll 1
    for (int rep = 0; rep < NREP(2); ++rep) {
        pg8::Gemm g{(const bf16_t*)p.out, (const bf16_t*)(p.ws + WS_W1T), MTOK, NHY, DM, DM};
        pg8::StaticOrder S; S.init(MTOK, NHY, G, bid);
        EpiHyT E{(bf16_t*)(p.ws + WS_HYT), lds + 131072};
        pg8::gemm_phase<EpiHyT, pg8::StaticOrder, GEMM_ALIGN, GEMM_SP2>(ldsl, g, S, E);
#if PROBE_REP == 12
        pg8::gemm_phase<EpiHyT, pg8::StaticOrder, GEMM_ALIGN, GEMM_SP2>(ldsl, g, S, E);
#endif
    }
#pragma unroll 1
    for (int rep = 0; rep < NREP(3); ++rep) {
        pg8::Gemm g{(const bf16_t*)p.out, (const bf16_t*)(p.ws + WS_W1T) + (size_t)NHY * DM, MTOK, NSG, DM, DM};
        pg8::StaticOrder S; S.init(MTOK, NSG, G, bid);
        EpiSg E{(bf16_t*)(p.ws + WS_SG)};
        pg8::gemm_phase<EpiSg, pg8::StaticOrder, GEMM_ALIGN, GEMM_SP2>(ldsl, g, S, E);
#if PROBE_REP == 13
        pg8::gemm_phase<EpiSg, pg8::StaticOrder, GEMM_ALIGN, GEMM_SP2>(ldsl, g, S, E);
#endif
    }
    xcd_barrier(xbar);

    { const cf* twg = (const cf*)(p.ws + WS_TW); cf* twl = (cf*)(lds + FFT_LDS_CF * 8 + 1024);
      for (int i = threadIdx.x; i < 2048; i += NT) twl[i] = twg[i];
      __syncthreads(); }
#if PROBE_REP == 4 || PROBE_REP == 5
#pragma unroll 1
    for (int rep = 0; rep < NREP(4); ++rep)
        for (int c = bid; c < 1024; c += G) hyena_job(p, c, lds, rep < NREP(4) - 1);
#pragma unroll 1
    for (int rep = 0; rep < NREP(5); ++rep)
        gmlp_phase(p, lds, rep < NREP(5) - 1);
#else
    {
        const int nhy = (1024 - bid + G - 1) / G, ngm = (2048 - bid + G - 1) / G;
        const int gper = (ngm + nhy - 1) / (nhy > 0 ? nhy : 1);
        const bool first = ((bid >> 3) & 1) != 0;
#pragma unroll 1
        for (int e = 0; e <= nhy; ++e) {
            int k0, nk;
            if (first) { k0 = e * gper; nk = (e < nhy) ? gper : ngm - k0; }
            else { k0 = (e - 1) * gper; nk = (e == 0) ? 0 : ((e < nhy) ? gper : ngm - k0); }
            if (nk > 0) gmlp_phase(p, lds, false, k0, nk);
            if (e < nhy) hyena_job(p, bid + G * e, lds, false);
        }
    }
#endif
    xcd_barrier(xbar);

#pragma unroll 1
    for (int rep = 0; rep < NREP(6); ++rep)
        ya_transpose_phase(p, lds);
    xcd_barrier(xbar);

#pragma unroll 1
    for (int rep = 0; rep < NREP(7); ++rep) {
        pg8::Gemm g{(const bf16_t*)(p.ws + WS_SG), (const bf16_t*)(p.ws + WS_W2T), MTOK, DM, 2048, NSG};
        pg8::StaticOrder S; S.init(MTOK, DM, G, bid);
        pg8::EpiBf16<0> E{(bf16_t*)(p.ws + WS_HYT), DM, nullptr, 0, 0};
        pg8::gemm_phase<pg8::EpiBf16<0>, pg8::StaticOrder, GEMM_ALIGN, GEMM_SP2>(ldsl, g, S, E);
#if PROBE_REP == 17
        pg8::gemm_phase<pg8::EpiBf16<0>, pg8::StaticOrder, GEMM_ALIGN, GEMM_SP2>(ldsl, g, S, E);
#endif
    }
    xcd_barrier(xbar);

#pragma unroll 1
    for (int rep = 0; rep < NREP(8); ++rep) phase5(p);
#if PROBE_REP == 9
    grid.sync(); grid.sync(); grid.sync(); grid.sync();
#endif
}

extern "C" void kernel_launch(void* const* d_in, const int* in_sizes, int n_in, void* d_out, int out_size, void* d_ws, size_t ws_size, hipStream_t stream) {
    static int grid_blocks = 0;
    if (grid_blocks == 0) {
        if (n_in != 22 || out_size != MTOK * DM || ws_size < WS_END) { fprintf(stderr, "kernel_launch: unexpected shapes (n_in %d out %d ws %zu need %zu)\n", n_in, out_size, ws_size, (size_t)WS_END); grid_blocks = -1; return; }
        int dev = 0, cus = 0, per_cu = 0;
        hipGetDevice(&dev);
        hipDeviceGetAttribute(&cus, hipDeviceAttributeMultiprocessorCount, dev);
        if (hipFuncSetAttribute((const void*)hyena_gmlp_fwd, hipFuncAttributeMaxDynamicSharedMemorySize, LDS_BYTES) != hipSuccess) { fprintf(stderr, "kernel_launch: hipFuncSetAttribute failed\n"); grid_blocks = -1; return; }
        if (hipOccupancyMaxActiveBlocksPerMultiprocessor(&per_cu, (const void*)hyena_gmlp_fwd, NT, LDS_BYTES) != hipSuccess || per_cu < 1) { fprintf(stderr, "kernel_launch: occupancy query says %d\n", per_cu); (void)hipGetLastError(); grid_blocks = -1; return; }
        grid_blocks = cus * per_cu;
        if (grid_blocks > 256) grid_blocks = 256;
    }
    if (grid_blocks < 0) return;
    Params p{};
    for (int i = 0; i < 22; ++i) p.in[i] = (const float*)d_in[i];
    p.out = (float*)d_out; p.ws = (unsigned char*)d_ws;
    void* args[] = {&p};
    hipError_t e = hipLaunchCooperativeKernel((const void*)hyena_gmlp_fwd, dim3(grid_blocks), dim3(NT), args, LDS_BYTES, stream);
    if (e != hipSuccess) fprintf(stderr, "cooperative launch failed: %s (grid %d)\n", hipGetErrorString(e), grid_blocks);
}
```

```cpp
#include <hip/hip_runtime.h>
#include <hip/hip_cooperative_groups.h>
#include <cstdio>
#include <cstdint>
namespace cg = cooperative_groups;

#define HD __host__ __device__ __forceinline__
typedef float cf __attribute__((ext_vector_type(2)));
constexpr int FFT_N = 16384;
constexpr int FFT_LDS_CF = FFT_N + (FFT_N >> 5) * 2 + (FFT_N >> 9) * 16;
HD int PADI(int i) { return i + ((i >> 5) << 1) + ((i >> 9) << 4); }
HD constexpr int PADOFF(int d) { return d + ((d >> 5) << 1) + ((d >> 9) << 4); }
HD cf cadd(cf a, cf b) { return a + b; }
HD cf csub(cf a, cf b) { return a - b; }
HD cf cmul(cf a, cf b) {
#if defined(__HIP_DEVICE_COMPILE__)
    cf t, r;
    asm("v_pk_mul_f32 %0, %1, %2 op_sel:[0,0] op_sel_hi:[0,1]" : "=v"(t) : "v"(a), "v"(b));
    asm("v_pk_fma_f32 %0, %1, %2, %3 op_sel:[1,1,0] op_sel_hi:[1,0,1] neg_lo:[0,1,0] neg_hi:[0,0,0]" : "=v"(r) : "v"(a), "v"(b), "v"(t));
    return r;
#else
    return cf{a.x * b.x - a.y * b.y, a.x * b.y + a.y * b.x};
#endif
}
template <bool INV> HD cf twc(cf a, float c, float s) { return INV ? __builtin_elementwise_fma(a.yx, cf{-s, s}, a * c) : __builtin_elementwise_fma(a.yx, cf{s, -s}, a * c); }
template <bool INV> HD cf mul_mi(cf a) { return INV ? cf{-a.y, a.x} : cf{a.y, -a.x}; }
template <bool INV> HD void dft4(cf& a0, cf& a1, cf& a2, cf& a3) {
    const cf t0 = cadd(a0, a2), t1 = csub(a0, a2), t2 = cadd(a1, a3), t3 = mul_mi<INV>(csub(a1, a3));
    a0 = cadd(t0, t2); a2 = csub(t0, t2); a1 = cadd(t1, t3); a3 = csub(t1, t3);
}
template <int R> HD constexpr int KIDX(int j) { return R == 32 ? ((j >> 3) + 4 * (((j & 7) >> 1) + 4 * (j & 1))) : R == 16 ? ((j >> 2) + 4 * (j & 3)) : ((j >> 1) + 4 * (j & 1)); }
template <int R> HD constexpr int JIDX(int k) { return R == 32 ? (8 * (k & 3) + 2 * ((k >> 2) & 3) + (k >> 4)) : R == 16 ? ((k >> 2) + 4 * (k & 3)) : (2 * (k & 3) + (k >> 2)); }
template <bool INV> HD void dft8r(cf& a0, cf& a1, cf& a2, cf& a3, cf& a4, cf& a5, cf& a6, cf& a7) {
    dft4<INV>(a0, a2, a4, a6);
    dft4<INV>(a1, a3, a5, a7);
    const float c = 0.70710678118654752f;
    a3 = twc<INV>(a3, c, c);
    a5 = mul_mi<INV>(a5);
    a7 = twc<INV>(a7, -c, c);
    { const cf e = a0, o = a1; a0 = cadd(e, o); a1 = csub(e, o); }
    { const cf e = a2, o = a3; a2 = cadd(e, o); a3 = csub(e, o); }
    { const cf e = a4, o = a5; a4 = cadd(e, o); a5 = csub(e, o); }
    { const cf e = a6, o = a7; a6 = cadd(e, o); a7 = csub(e, o); }
}
template <bool INV> HD void dft8(cf (&a)[8]) { dft8r<INV>(a[0], a[1], a[2], a[3], a[4], a[5], a[6], a[7]); }
template <bool INV> HD void dft8h(cf& a0, cf& a1, cf& a2, cf& a3, cf& a4, cf& a5, cf& a6, cf& a7) {
    dft4<INV>(a0, a2, a4, a6);
    dft4<INV>(a1, a3, a5, a7);
    const float c = 0.70710678118654752f;
    a3 = twc<INV>(a3, c, c);
    a5 = mul_mi<INV>(a5);
    a7 = twc<INV>(a7, -c, c);
    a0 = cadd(a0, a1); a2 = cadd(a2, a3); a4 = cadd(a4, a5); a6 = cadd(a6, a7);
}
template <bool INV> HD void dft16(cf (&a)[16]) {
#pragma unroll
    for (int s = 0; s < 4; ++s) dft4<INV>(a[s], a[s + 4], a[s + 8], a[s + 12]);
    const float c1 = 0.92387953251128674f, s1 = 0.38268343236508977f, c2 = 0.70710678118654752f;
    a[1 + 4] = twc<INV>(a[1 + 4], c1, s1);
    a[2 + 4] = twc<INV>(a[2 + 4], c2, c2);
    a[3 + 4] = twc<INV>(a[3 + 4], s1, c1);
    a[1 + 8] = twc<INV>(a[1 + 8], c2, c2);
    a[2 + 8] = mul_mi<INV>(a[2 + 8]);
    a[3 + 8] = twc<INV>(a[3 + 8], -c2, c2);
    a[1 + 12] = twc<INV>(a[1 + 12], s1, c1);
    a[2 + 12] = twc<INV>(a[2 + 12], -c2, c2);
    a[3 + 12] = twc<INV>(a[3 + 12], -c1, -s1);
#pragma unroll
    for (int k1 = 0; k1 < 4; ++k1) dft4<INV>(a[4 * k1], a[4 * k1 + 1], a[4 * k1 + 2], a[4 * k1 + 3]);
}
template <bool INV, int MODE> HD void dft32m(cf (&a)[32]) {
    constexpr float C32[22] = {1.000000000e+00f, 9.807852804e-01f, 9.238795325e-01f, 8.314696123e-01f, 7.071067812e-01f, 5.555702330e-01f, 3.826834324e-01f, 1.950903220e-01f, 0.000000000e+00f, -1.950903220e-01f, -3.826834324e-01f, -5.555702330e-01f, -7.071067812e-01f, -8.314696123e-01f, -9.238795325e-01f, -9.807852804e-01f, -1.000000000e+00f, -9.807852804e-01f, -9.238795325e-01f, -8.314696123e-01f, -7.071067812e-01f, -5.555702330e-01f};
    constexpr float S32[22] = {0.000000000e+00f, 1.950903220e-01f, 3.826834324e-01f, 5.555702330e-01f, 7.071067812e-01f, 8.314696123e-01f, 9.238795325e-01f, 9.807852804e-01f, 1.000000000e+00f, 9.807852804e-01f, 9.238795325e-01f, 8.314696123e-01f, 7.071067812e-01f, 5.555702330e-01f, 3.826834324e-01f, 1.950903220e-01f, 0.000000000e+00f, -1.950903220e-01f, -3.826834324e-01f, -5.555702330e-01f, -7.071067812e-01f, -8.314696123e-01f};
    if constexpr (MODE == 1) {
#pragma unroll
        for (int s = 0; s < 8; ++s) { const cf t0 = a[s], t3 = mul_mi<INV>(a[s + 8]); const cf t2 = a[s + 8];
            a[s] = cadd(t0, t2); a[s + 16] = csub(t0, t2); a[s + 8] = cadd(t0, t3); a[s + 24] = csub(t0, t3); }
    } else {
#pragma unroll
        for (int s = 0; s < 8; ++s) dft4<INV>(a[s], a[s + 8], a[s + 16], a[s + 24]);
    }
#pragma unroll
    for (int k1 = 1; k1 < 4; ++k1)
#pragma unroll
        for (int s = 1; s < 8; ++s) { const int e = s * k1;
            if (e == 8) a[s + 8 * k1] = mul_mi<INV>(a[s + 8 * k1]); else a[s + 8 * k1] = twc<INV>(a[s + 8 * k1], C32[e], S32[e]); }
#pragma unroll
    for (int k1 = 0; k1 < 4; ++k1) {
        if constexpr (MODE == 2) dft8h<INV>(a[8 * k1], a[8 * k1 + 1], a[8 * k1 + 2], a[8 * k1 + 3], a[8 * k1 + 4], a[8 * k1 + 5], a[8 * k1 + 6], a[8 * k1 + 7]);
        else dft8r<INV>(a[8 * k1], a[8 * k1 + 1], a[8 * k1 + 2], a[8 * k1 + 3], a[8 * k1 + 4], a[8 * k1 + 5], a[8 * k1 + 6], a[8 * k1 + 7]);
    }
}
template <bool INV> HD void dft32(cf (&a)[32]) { dft32m<INV, 0>(a); }
template <int R, bool INV> HD void dftR(cf (&a)[R]) { if constexpr (R == 32) dft32<INV>(a); else if constexpr (R == 16) dft16<INV>(a); else dft8<INV>(a); }
template <int R, bool INV, int S, int TWS, int MODE = 0, class XP, class TP>
HD void fft_stage(XP X, TP tw, int tid, int nthreads) {
    constexpr int NB = FFT_N / R;
#pragma unroll 2
    for (int g = tid; g < NB; g += nthreads) {
        const int np = g & (S - 1);
        const int base = (g - np) * R + np;
        const int pb = PADI(base);
        cf a[R];
#pragma unroll
        for (int j = 0; j < R; ++j) { if (MODE == 1 && j >= R / 2) a[j] = cf{0.f, 0.f}; else a[j] = X[pb + PADOFF(j * S)]; }
        cf w = cf{1.f, 0.f};
        if constexpr (TWS != 0) { w = tw[np * TWS]; if (INV) w.y = -w.y; }
        if constexpr (INV && TWS != 0) {
            cf p = w;
#pragma unroll
            for (int j = 1; j < R; ++j) { a[j] = cmul(a[j], p); p = cmul(p, w); }
        }
        if constexpr (R == 32 && MODE != 0) dft32m<INV, MODE>(a); else dftR<R, INV>(a);
        if constexpr (!INV && TWS != 0) {
            cf p = w;
#pragma unroll
            for (int k = 1; k < R; ++k) { a[JIDX<R>(k)] = cmul(a[JIDX<R>(k)], p); p = cmul(p, w); }
        }
#pragma unroll
        for (int j = 0; j < R; ++j) { if (MODE == 2 && KIDX<R>(j) >= R / 2) continue; X[pb + PADOFF(KIDX<R>(j) * S)] = a[j]; }
    }
}
namespace pg8 {
#define PG8_LAS __attribute__((address_space(3)))
typedef unsigned short bf16_t;
typedef short bf16x8 __attribute__((ext_vector_type(8)));
typedef float f32x4 __attribute__((ext_vector_type(4)));
typedef unsigned u32x4 __attribute__((ext_vector_type(4)));
constexpr int BM = 256, BK = 64, HALF = 128, HTB = HALF * BK * 2  , STAGE_BYTES = 8 * HTB, NXCD = 8, WGM = 8;

__host__ __device__ __forceinline__ int lds_byte(int r, int c) { const int st = (r >> 4) * 2 + (c >> 5), rr = r & 15, cc = c & 31, ob = rr * 64 + cc * 2; return st * 1024 + (ob ^ (((ob >> 9) & 1) << 5)); }
__host__ __device__ __forceinline__ void stage_rc(int b, int& R, int& C) { const int st = b / 1024, sb = b % 1024, swz = sb ^ (((sb >> 9) & 1) << 5); R = (st >> 1) * 16 + swz / 64; C = (st & 1) * 32 + (swz % 64) / 2; }
__host__ __device__ __forceinline__ int perm32(int rho) { const int n = rho >> 4, i = rho & 15; return 8 * (i >> 2) + 4 * n + (i & 3); }

struct Unit { int pm, pn; };
struct Gemm { const bf16_t* A; const bf16_t* Bt; int M, N, K, lda; };

struct StaticOrder {
    int nM, nN, nwg, G, c;
    __host__ __device__ void init(int M, int N, int G_, int c_) { nM = M / BM; nN = N / BM; nwg = nM * nN; G = G_; c = c_; }
    __host__ __device__ bool next(int i, Unit& u) const {
        const long L = (long)i * G + c; if (L >= nwg) return false;
        int wgid = (int)L; { const int q = nwg / NXCD, r = nwg % NXCD, xcd = wgid % NXCD, off = wgid / NXCD; wgid = (xcd < r ? xcd * (q + 1) : r * (q + 1) + (xcd - r) * q) + off; }
        const int nig = WGM * nN, gid = wgid / nig, fm = gid * WGM, gsz = (nM - fm) < WGM ? (nM - fm) : WGM;
        u.pm = fm + ((wgid % nig) % gsz); u.pn = (wgid % nig) / gsz; return true;
    }
    __device__ __forceinline__ void a_ready(const Unit&) const {}
    __device__ __forceinline__ void done(const Unit&) const {}
};
__device__ __forceinline__ unsigned cvt_pk_bf16(float lo, float hi) { unsigned r; asm volatile("v_cvt_pk_bf16_f32 %0, %1, %2" : "=v"(r) : "v"(lo), "v"(hi)); return r; }
typedef float f32x2 __attribute__((ext_vector_type(2)));
__device__ __forceinline__ f32x2 gelu_pk(f32x2 v) {
    const f32x2 av = __builtin_elementwise_abs(v), d = av * 0.2316418882f + 1.0f;
    f32x2 t; t.x = __builtin_amdgcn_rcpf(d.x); t.y = __builtin_amdgcn_rcpf(d.y);
    f32x2 q = t * 0.5307027145f + (-0.7265760135f); q = q * t + 0.7107068705f; q = q * t + (-0.142248368f); q = q * t + 0.127414796f; q = q * t;
    const f32x2 s = (v * v) * (-0.72134752044f);
    f32x2 e; e.x = __builtin_amdgcn_exp2f(s.x); e.y = __builtin_amdgcn_exp2f(s.y);
    const f32x2 m = v * (q * e), r = v - m;
    f32x2 o; o.x = v.x < 0.f ? m.x : r.x; o.y = v.y < 0.f ? m.y : r.y; return o;
}

struct EpiF32 {
    static constexpr bool PERM = false, AFTER_DRAIN = false, SWAP = false;
    float* C; int ldc; const float* bias;
    __device__ __forceinline__ void operator()(const f32x4 (&acc)[2][2][4][2], const Unit& u, int wr, int wc, int fr, int fq) const {
        const int row0 = u.pm * BM + wr * 64 + fr, col0 = u.pn * BM + wc * 32 + 4 * fq;
        f32x4 bv[2][2];
#pragma unroll
        for (int bj = 0; bj < 2; ++bj)
#pragma unroll
            for (int n = 0; n < 2; ++n) bv[bj][n] = bias ? *(const f32x4*)(bias + col0 + bj * HALF + n * 16) : (f32x4){0.f, 0.f, 0.f, 0.f};
#pragma unroll
        for (int ai = 0; ai < 2; ++ai)
#pragma unroll
            for (int m = 0; m < 4; ++m) { float* rowp = C + (size_t)(row0 + ai * HALF + m * 16) * ldc + col0;
#pragma unroll
                for (int bj = 0; bj < 2; ++bj)
#pragma unroll
                    for (int n = 0; n < 2; ++n) *(f32x4*)(rowp + bj * HALF + n * 16) = acc[ai][bj][m][n] + bv[bj][n]; }
    }
};
template <int ACT  > struct EpiBf16 {
    static constexpr bool PERM = true, AFTER_DRAIN = false, SWAP = false;
    bf16_t* O; int ldc; const float* bias; int split_cols; size_t split_stride;
    __device__ __forceinline__ void operator()(const f32x4 (&acc)[2][2][4][2], const Unit& u, int wr, int wc, int fr, int fq) const {
        const int row0 = u.pm * BM + wr * 64 + fr; int colt = u.pn * BM; bf16_t* base = O;
        if (split_cols) { const int t = colt / split_cols; base += (size_t)t * split_stride; colt -= t * split_cols; }
        const int col0 = colt + wc * 32 + 8 * fq, bcol0 = u.pn * BM + wc * 32 + 8 * fq;
        f32x4 bv[2][2];
#pragma unroll
        for (int bj = 0; bj < 2; ++bj)
#pragma unroll
            for (int n = 0; n < 2; ++n) bv[bj][n] = bias ? *(const f32x4*)(bias + bcol0 + bj * HALF + 4 * n) : (f32x4){0.f, 0.f, 0.f, 0.f};
#pragma unroll
        for (int ai = 0; ai < 2; ++ai)
#pragma unroll
            for (int m = 0; m < 4; ++m) { bf16_t* rowp = base + (size_t)(row0 + ai * HALF + m * 16) * ldc + col0;
#pragma unroll
                for (int bj = 0; bj < 2; ++bj) { f32x4 v0 = acc[ai][bj][m][0] + bv[bj][0], v1 = acc[ai][bj][m][1] + bv[bj][1];
                    if (ACT == 1) { f32x2 a = gelu_pk((f32x2){v0[0], v0[1]}), b = gelu_pk((f32x2){v0[2], v0[3]}), c = gelu_pk((f32x2){v1[0], v1[1]}), d = gelu_pk((f32x2){v1[2], v1[3]});
                        v0 = (f32x4){a.x, a.y, b.x, b.y}; v1 = (f32x4){c.x, c.y, d.x, d.y}; }
                    if (ACT == 2) {
#pragma unroll
                        for (int j = 0; j < 4; ++j) { v0[j] = 0.5f * v0[j] * (1.0f + erff(v0[j] * 0.70710678f)); v1[j] = 0.5f * v1[j] * (1.0f + erff(v1[j] * 0.70710678f)); } }
                    u32x4 w; w.x = cvt_pk_bf16(v0[0], v0[1]); w.y = cvt_pk_bf16(v0[2], v0[3]); w.z = cvt_pk_bf16(v1[0], v1[1]); w.w = cvt_pk_bf16(v1[2], v1[3]);
                    *(u32x4*)(rowp + bj * HALF) = w; } }
    }
};
template <class Epi, class Sched, bool ALIGN_EPI = false, bool SP2 = false>
__device__ __forceinline__ void gemm_phase(PG8_LAS unsigned char* lds, const Gemm g, const Sched& S, const Epi& E) {
    const int tid = threadIdx.x, wid = __builtin_amdgcn_readfirstlane(tid >> 6), lane = tid & 63, wr = wid >> 2, wc = wid & 3, fr = lane & 15, fq = lane >> 4;
    const int K = g.K, nt = K / BK;
    unsigned voffA[2], voffB[2];
#pragma unroll
    for (int i = 0; i < 2; ++i) { int R, C; stage_rc(tid * 16 + i * 8192, R, C); const int Rb = Epi::PERM ? ((R & ~31) + perm32(R & 31)) : R;
        voffA[i] = (unsigned)(R * g.lda + C) * 2u; voffB[i] = (unsigned)(Rb * K + C) * 2u; }
    const size_t kstep = (size_t)(BK * 2);
    const size_t hstepA = (size_t)HALF * g.lda * 2, hstepB = (size_t)HALF * K * 2;
    const size_t tstepA = 2 * hstepA, tstepB = 2 * hstepB;
    const unsigned ldsw = (unsigned)wid * 1024u;
    const int aoff = lds_byte(wr * 64 + fr, fq * 8), boff = lds_byte(wc * 32 + fr, fq * 8);
#define PG8_SA(b, h) (((b) * 2 + (h)) * HTB)
#define PG8_SB(b, h) ((4 + (b) * 2 + (h)) * HTB)
#define PG8_STAGE(bufoff, gbase, voff) do { _Pragma("unroll") for (int _i = 0; _i < 2; ++_i) \
        __builtin_amdgcn_global_load_lds((const unsigned*)((const char*)(gbase) + (voff)[_i]), (PG8_LAS unsigned*)(lds + (bufoff) + ldsw + _i * 8192), 16, 0, 0); } while (0)
#define PG8_LDA(dst, b, h) do { _Pragma("unroll") for (int m = 0; m < 4; ++m) _Pragma("unroll") for (int k = 0; k < 2; ++k) dst[m][k] = *(const PG8_LAS bf16x8*)(lds + PG8_SA(b, h) + aoff + m * 2048 + k * 1024); } while (0)
#define PG8_LDB(dst, b, h) do { _Pragma("unroll") for (int n = 0; n < 2; ++n) _Pragma("unroll") for (int k = 0; k < 2; ++k) dst[n][k] = *(const PG8_LAS bf16x8*)(lds + PG8_SB(b, h) + boff + n * 2048 + k * 1024); } while (0)
#define PG8_MMA(ai, bj, At, Bt) do { __builtin_amdgcn_s_setprio(1); _Pragma("unroll") for (int m = 0; m < 4; ++m) _Pragma("unroll") for (int n = 0; n < 2; ++n) _Pragma("unroll") for (int k = 0; k < 2; ++k) \
        acc[ai][bj][m][n] = Epi::SWAP ? __builtin_amdgcn_mfma_f32_16x16x32_bf16(At[m][k], Bt[n][k], acc[ai][bj][m][n], 0, 0, 0) : __builtin_amdgcn_mfma_f32_16x16x32_bf16(Bt[n][k], At[m][k], acc[ai][bj][m][n], 0, 0, 0); __builtin_amdgcn_s_setprio(0); } while (0)
#define PG8_WAIT_V(n) asm volatile("s_waitcnt vmcnt(" #n ")" ::: "memory")
#define PG8_WAIT_L(n) asm volatile("s_waitcnt lgkmcnt(" #n ")" ::: "memory")
#define PG8_BAR __builtin_amdgcn_s_barrier()
#define PG8_SCHED __builtin_amdgcn_sched_barrier(0)
    Unit cur, nxt; int ui = 0;
    if (!S.next(0, cur)) return;
    f32x4 acc[2][2][4][2];
#pragma unroll
    for (int a = 0; a < 2; ++a)
#pragma unroll
        for (int b = 0; b < 2; ++b)
#pragma unroll
            for (int m = 0; m < 4; ++m)
#pragma unroll
                for (int n = 0; n < 2; ++n) acc[a][b][m][n] = (f32x4){0.f, 0.f, 0.f, 0.f};
    bf16x8 At[4][2], B0[2][2], B1[2][2];
    const char* cA = (const char*)g.A + (size_t)cur.pm * tstepA; const char* cB = (const char*)g.Bt + (size_t)cur.pn * tstepB;
    S.a_ready(cur);
    if constexpr (SP2) {
        PG8_STAGE(PG8_SB(0, 0), cB, voffB); PG8_STAGE(PG8_SB(0, 1), cB + hstepB, voffB); PG8_STAGE(PG8_SA(0, 0), cA, voffA); PG8_STAGE(PG8_SA(0, 1), cA + hstepA, voffA);
        if (wr == 1) PG8_BAR;
        PG8_WAIT_V(2); PG8_BAR;
        PG8_STAGE(PG8_SB(1, 0), cB + kstep, voffB); PG8_STAGE(PG8_SA(1, 0), cA + kstep, voffA); PG8_STAGE(PG8_SB(1, 1), cB + hstepB + kstep, voffB);
        PG8_WAIT_V(6); PG8_BAR;
    } else {
        PG8_STAGE(PG8_SB(0, 0), cB, voffB); PG8_STAGE(PG8_SA(0, 0), cA, voffA); PG8_STAGE(PG8_SB(0, 1), cB + hstepB, voffB); PG8_STAGE(PG8_SA(0, 1), cA + hstepA, voffA);
        if (wr == 1) PG8_BAR;
        PG8_WAIT_V(4); PG8_BAR;
        PG8_STAGE(PG8_SB(1, 0), cB + kstep, voffB); PG8_STAGE(PG8_SA(1, 0), cA + kstep, voffA); PG8_STAGE(PG8_SB(1, 1), cB + hstepB + kstep, voffB);
        PG8_WAIT_V(6); PG8_BAR;
    }
    for (;;) {
        const bool has_next = S.next(ui + 1, nxt);
        const char* nA = has_next ? (const char*)g.A + (size_t)nxt.pm * tstepA : cA; const char* nB = has_next ? (const char*)g.Bt + (size_t)nxt.pn * tstepB : cB;
        for (int t = 0; t < nt; t += 2) {
            const bool last = (t == nt - 2);
            const char* a1 = cA + (size_t)(t + 1) * kstep;
            const char* a2 = last ? nA : cA + (size_t)(t + 2) * kstep; const char* b2 = last ? nB : cB + (size_t)(t + 2) * kstep;
            const char* a3 = a2 + kstep; const char* b3 = b2 + kstep;
            if (last && has_next) S.a_ready(nxt);
            if constexpr (SP2) {
            PG8_LDB(B0, 0, 0); PG8_LDB(B1, 0, 1); PG8_SCHED; PG8_LDA(At, 0, 0); PG8_STAGE(PG8_SA(1, 1), a1 + hstepA, voffA);
            PG8_WAIT_V(8); PG8_WAIT_L(0); PG8_BAR; PG8_MMA(0, 0, At, B0); PG8_MMA(0, 1, At, B1); PG8_BAR; PG8_SCHED;
            PG8_LDA(At, 0, 1); PG8_STAGE(PG8_SB(0, 0), b2, voffB); PG8_STAGE(PG8_SB(0, 1), b2 + hstepB, voffB); PG8_STAGE(PG8_SA(0, 0), a2, voffA);
            PG8_WAIT_V(8); PG8_WAIT_L(0); PG8_BAR; PG8_MMA(1, 0, At, B0); PG8_MMA(1, 1, At, B1); PG8_BAR; PG8_SCHED;
            PG8_LDB(B0, 1, 0); PG8_LDB(B1, 1, 1); PG8_SCHED; PG8_LDA(At, 1, 0); PG8_STAGE(PG8_SA(0, 1), a2 + hstepA, voffA);
            PG8_WAIT_V(8); PG8_WAIT_L(0); PG8_BAR; PG8_MMA(0, 0, At, B0); PG8_MMA(0, 1, At, B1); PG8_BAR; PG8_SCHED;
            PG8_LDA(At, 1, 1); PG8_STAGE(PG8_SB(1, 0), b3, voffB); PG8_STAGE(PG8_SB(1, 1), b3 + hstepB, voffB); PG8_STAGE(PG8_SA(1, 0), a3, voffA);
            PG8_WAIT_V(8); PG8_WAIT_L(0); PG8_BAR; PG8_MMA(1, 0, At, B0); PG8_MMA(1, 1, At, B1); PG8_BAR; PG8_SCHED;
            } else {
            PG8_LDB(B0, 0, 0); PG8_SCHED; PG8_LDA(At, 0, 0); PG8_STAGE(PG8_SA(1, 1), a1 + hstepA, voffA);
            PG8_WAIT_L(8); PG8_BAR; PG8_WAIT_L(0); PG8_MMA(0, 0, At, B0); PG8_BAR; PG8_SCHED;
            PG8_LDB(B1, 0, 1); PG8_STAGE(PG8_SB(0, 0), b2, voffB);
            PG8_BAR; PG8_WAIT_L(0); PG8_MMA(0, 1, At, B1); PG8_BAR;
            PG8_LDA(At, 0, 1); PG8_STAGE(PG8_SA(0, 0), a2, voffA);
            PG8_BAR; PG8_WAIT_L(0); PG8_MMA(1, 0, At, B0); PG8_BAR; PG8_SCHED;
            PG8_STAGE(PG8_SB(0, 1), b2 + hstepB, voffB);
            PG8_WAIT_V(6); PG8_BAR; PG8_MMA(1, 1, At, B1); PG8_BAR;
            PG8_LDB(B0, 1, 0); PG8_SCHED; PG8_LDA(At, 1, 0); PG8_STAGE(PG8_SA(0, 1), a2 + hstepA, voffA);
            PG8_WAIT_L(8); PG8_BAR; PG8_WAIT_L(0); PG8_MMA(0, 0, At, B0); PG8_BAR; PG8_SCHED;
            PG8_LDB(B1, 1, 1); PG8_STAGE(PG8_SB(1, 0), b3, voffB);
            PG8_BAR; PG8_WAIT_L(0); PG8_MMA(0, 1, At, B1); PG8_BAR;
            PG8_LDA(At, 1, 1); PG8_STAGE(PG8_SA(1, 0), a3, voffA);
            PG8_BAR; PG8_WAIT_L(0); PG8_MMA(1, 0, At, B0); PG8_BAR; PG8_SCHED;
            PG8_STAGE(PG8_SB(1, 1), b3 + hstepB, voffB);
            PG8_WAIT_V(6); PG8_BAR; PG8_MMA(1, 1, At, B1); PG8_BAR;
            }
        }
        if constexpr (ALIGN_EPI) { if (wr == 0) PG8_BAR; }
        if constexpr (!Epi::AFTER_DRAIN) { E(acc, cur, wr, wc, fr, fq); S.done(cur); }
        if (!has_next) break;
#pragma unroll
        for (int a = 0; a < 2; ++a)
#pragma unroll
            for (int b = 0; b < 2; ++b)
#pragma unroll
                for (int m = 0; m < 4; ++m)
#pragma unroll
                    for (int n = 0; n < 2; ++n) acc[a][b][m][n] = (f32x4){0.f, 0.f, 0.f, 0.f};
        cur = nxt; cA = nA; cB = nB; ++ui;
        if constexpr (ALIGN_EPI) { if (wr == 1) PG8_BAR; }
    }
    PG8_WAIT_V(0);
    if constexpr (!ALIGN_EPI) { if (wr == 0) PG8_BAR; }
    PG8_BAR;
    if constexpr (Epi::AFTER_DRAIN) { E.fused(acc, cur, wr, wc, fr, fq, lds, wid, lane); S.done(cur); }
#undef PG8_SA
#undef PG8_SB
#undef PG8_STAGE
#undef PG8_LDA
#undef PG8_LDB
#undef PG8_MMA
#undef PG8_WAIT_V
#undef PG8_WAIT_L
#undef PG8_BAR
#undef PG8_SCHED
}
}

#ifndef PROBE_REP
#define PROBE_REP 0
#endif
#define NREP(k) ((PROBE_REP == (k)) ? 2 : 1)
constexpr int NT = 512;
#ifndef GEMM_SP2
#define GEMM_SP2 true
#endif
#ifndef GEMM_ALIGN
#define GEMM_ALIGN true
#endif
constexpr int BATCH = 4, SEQ = 8192, DM = 1024, MTOK = BATCH * SEQ, DIN = 7168, NHY = 4096, NSG = 3072;
constexpr float EPSF = 1e-6f;
constexpr size_t MiB = 1024ull * 1024ull;
constexpr size_t WS_W1T = 0;
constexpr size_t WS_W2T = WS_W1T + 14 * MiB;
constexpr size_t WS_TW = WS_W2T + 4 * MiB;
constexpr size_t WS_BAR = WS_TW + 16 * 1024;
constexpr size_t WS_SGW = WS_TW + 64 * 1024;
constexpr size_t WS_KSCR = WS_W2T + 5 * MiB;
constexpr size_t WS_HYT = WS_KSCR + 32 * MiB;
constexpr size_t WS_SG = WS_HYT + 256 * MiB;
constexpr size_t WS_END = WS_SG + 192 * MiB;
constexpr int LDS_ST_OFF = FFT_LDS_CF * 8 + 1024 + 2048 * 8;
constexpr int LDS_BYTES = LDS_ST_OFF + 16;

typedef unsigned short bf16_t;
typedef short bf16x8 __attribute__((ext_vector_type(8)));
typedef float f32x4 __attribute__((ext_vector_type(4)));

struct Params {
    const float* in[22];
    float* out;
    unsigned char* ws;
};

__device__ __forceinline__ unsigned pk_bf16(float lo, float hi) { unsigned r; asm volatile("v_cvt_pk_bf16_f32 %0, %1, %2" : "=v"(r) : "v"(lo), "v"(hi)); return r; }
__device__ __forceinline__ bf16_t f2bf(float f) { return (bf16_t)(pk_bf16(f, 0.f) & 0xffffu); }
__device__ __forceinline__ float bf_lo(unsigned u) { return __uint_as_float(u << 16); }
__device__ __forceinline__ float bf_hi(unsigned u) { return __uint_as_float(u & 0xffff0000u); }
__device__ __forceinline__ float bf2f(bf16_t b) { return __uint_as_float(((unsigned)b) << 16); }
__device__ __forceinline__ float siluf(float x) { return x * __builtin_amdgcn_rcpf(1.0f + __expf(-x)); }
__device__ __forceinline__ float wave_sum(float v) {
#pragma unroll
    for (int o = 32; o >= 1; o >>= 1) v += __shfl_xor(v, o);
    return v;
}

#define XB_TMO      128
#define XB_XCNT(j)  (256  + 64 * (j))
#define XB_XSUB(j)  (1280 + 64 * (j))
#define XB_XGEN(j)  (2304 + 64 * (j))
#define XB_TOP      3328
#define XB_TOPGEN   3392
#define XCD_BAR_WORDS 3456
#define XB_SPIN_CAP (1u << 18)
#define XB_LAS __attribute__((address_space(3)))

__device__ __forceinline__ unsigned xb_ld(unsigned* p)              { return __hip_atomic_load(p, __ATOMIC_RELAXED, __HIP_MEMORY_SCOPE_AGENT); }
__device__ __forceinline__ unsigned xb_add(unsigned* p, unsigned v) { return __hip_atomic_fetch_add(p, v, __ATOMIC_RELAXED, __HIP_MEMORY_SCOPE_AGENT); }
__device__ __forceinline__ unsigned xb_xcc_id() { return (unsigned)__builtin_amdgcn_s_getreg((3 << 11) | 20) & 0xFu; }
#define XB_SPIN(cond, bar) do { unsigned _sp = 0; while (cond) { __builtin_amdgcn_s_sleep(1); \
    if ((++_sp & 255u) == 0u) { if (xb_ld(&(bar)[XB_TMO])) break; if (_sp > XB_SPIN_CAP) { atomicAdd(&(bar)[XB_TMO], 1u); break; } } } } while (0)

struct XcdBarrier {
    unsigned* bar; unsigned x;
    volatile XB_LAS unsigned* st;
};

__device__ __forceinline__ XcdBarrier xcd_barrier_post(unsigned* bar, volatile XB_LAS unsigned* st) {
    XcdBarrier b; b.bar = bar; b.x = xb_xcc_id(); b.st = st;
    if (threadIdx.x == 0) (void)xb_add(&bar[XB_XCNT(b.x)], 1u);
    return b;
}
__device__ __forceinline__ void xcd_barrier_complete(unsigned* bar, unsigned x, unsigned& nloc, unsigned& nx) {
    const unsigned G = gridDim.x * gridDim.y * gridDim.z;
    unsigned sum, cnt, mine, sp = 0u;
    for (;;) {
        sum = 0u; cnt = 0u; mine = 0u;
#pragma unroll
        for (unsigned j = 0; j < 16; ++j) { const unsigned c = xb_ld(&bar[XB_XCNT(j)]); sum += c; cnt += (c > 0u) ? 1u : 0u; mine = (j == x) ? c : mine; }
        if (sum == G) break;
        __builtin_amdgcn_s_sleep(1);
        if ((++sp & 255u) == 0u) { if (xb_ld(&bar[XB_TMO])) break; if (sp > XB_SPIN_CAP) { atomicAdd(&bar[XB_TMO], 1u); break; } }
    }
    nloc = mine > 0u ? mine : 1u; nx = cnt > 0u ? cnt : 1u;
}

__device__ __forceinline__ void xcd_barrier(const XcdBarrier& b) {
    asm volatile("s_waitcnt vmcnt(0)" ::: "memory");
    __syncthreads();
    if (threadIdx.x == 0) {
        unsigned* bar = b.bar;
        __builtin_amdgcn_s_waitcnt(0);
        unsigned nloc = b.st[0], nx = b.st[1];
        if (nloc == 0u) { xcd_barrier_complete(bar, b.x, nloc, nx); b.st[0] = nloc; b.st[1] = nx; }
        const unsigned old = xb_add(&bar[XB_XSUB(b.x)], 1u);
        const unsigned gen = old / nloc;
        if (old + 1u == (gen + 1u) * nloc) {
            __builtin_amdgcn_fence(__ATOMIC_RELEASE, "agent");
            asm volatile("s_waitcnt vmcnt(0)" ::: "memory");
            const unsigned og = xb_add(&bar[XB_TOP], 1u);
            const unsigned tg = og / nx;
            if (og + 1u == (tg + 1u) * nx) xb_add(&bar[XB_TOPGEN], 1u);
            else XB_SPIN(xb_ld(&bar[XB_TOPGEN]) == tg, bar);
            __builtin_amdgcn_fence(__ATOMIC_ACQUIRE, "agent");
            xb_add(&bar[XB_XGEN(b.x)], 1u);
            asm volatile("s_waitcnt vmcnt(0)" ::: "memory");
        } else {
            XB_SPIN(xb_ld(&bar[XB_XGEN(b.x)]) == gen, bar);
            __builtin_amdgcn_fence(__ATOMIC_ACQUIRE, "agent");
            asm volatile("s_waitcnt vmcnt(0)" ::: "memory");
        }
    }
    __syncthreads();
}

__device__ __forceinline__ int w1t_src_col(int nt) {
    if (nt < 64) return nt * 64;
    const int t = nt - 64, pn = t >> 2, sub = t & 3;
    return pn < 8 ? (sub < 2 ? 4096 + 128 * pn + 64 * sub : 6144 + 128 * pn + 64 * (sub - 2)) : 5120 + 256 * (pn - 8) + 64 * sub;
}
struct TrTile { const float* src; bf16_t* dst; };
__device__ __forceinline__ void weight_transposes(const Params& p, unsigned char* lds) {
    bf16_t* T = (bf16_t*)lds;
    bf16_t* W1T = (bf16_t*)(p.ws + WS_W1T); bf16_t* W2T = (bf16_t*)(p.ws + WS_W2T);
    const int tid = threadIdx.x, G = gridDim.x;
    const int k = tid >> 3, nc = (tid & 7) * 4;
#define TR_DESC(t, SRC, LDSRC, DST, LDDST) do { if ((t) < 1792) { const int kt = (t) & 15, nt = (t) >> 4; SRC = p.in[2] + (size_t)(kt * 64) * DIN + w1t_src_col(nt); LDSRC = DIN; DST = W1T + (size_t)(nt * 64) * DM + kt * 64; LDDST = DM; } \
        else { const int u = (t) - 1792, kt = u & 31, nt = u >> 5; SRC = p.in[20] + (size_t)(kt * 64) * DM + nt * 64; LDSRC = DM; DST = W2T + (size_t)(nt * 64) * 2048 + ((kt * 64 + 1024) & 2047); LDDST = 2048; } } while (0)
    int t = blockIdx.x;
    if (t >= 1792 + 512) return;
    const float* src; bf16_t* dst; int ldsrc, lddst;
    TR_DESC(t, src, ldsrc, dst, lddst);
    float4 a = *(const float4*)(src + (size_t)k * ldsrc + nc), b = *(const float4*)(src + (size_t)k * ldsrc + nc + 32);
    for (; t < 1792 + 512; t += G) {
        T[(nc + 0) * 72 + k] = f2bf(a.x); T[(nc + 1) * 72 + k] = f2bf(a.y); T[(nc + 2) * 72 + k] = f2bf(a.z); T[(nc + 3) * 72 + k] = f2bf(a.w);
        T[(nc + 32) * 72 + k] = f2bf(b.x); T[(nc + 33) * 72 + k] = f2bf(b.y); T[(nc + 34) * 72 + k] = f2bf(b.z); T[(nc + 35) * 72 + k] = f2bf(b.w);
        bf16_t* dcur = dst; const int ldcur = lddst;
        const int tn = t + G;
        if (tn < 1792 + 512) { TR_DESC(tn, src, ldsrc, dst, lddst); a = *(const float4*)(src + (size_t)k * ldsrc + nc); b = *(const float4*)(src + (size_t)k * ldsrc + nc + 32); }
        __syncthreads();
        { const int n = tid >> 3, kc = (tid & 7) * 8;
          const uint4 v = *(const uint4*)(T + n * 72 + kc);
          *(uint4*)(dcur + (size_t)n * ldcur + kc) = v; }
        __syncthreads();
    }
#undef TR_DESC
}

__device__ __forceinline__ void lds_barrier0() { asm volatile("s_waitcnt lgkmcnt(0)" ::: "memory"); __builtin_amdgcn_s_barrier(); asm volatile("" ::: "memory"); }
__device__ __forceinline__ void half_barrier(unsigned* ctr, unsigned& ph) {
    asm volatile("s_waitcnt lgkmcnt(0)" ::: "memory");
    ph += 4u;
    if ((threadIdx.x & 63) == 0) __hip_atomic_fetch_add(ctr, 1u, __ATOMIC_RELAXED, __HIP_MEMORY_SCOPE_WORKGROUP);
    while (__hip_atomic_load(ctr, __ATOMIC_RELAXED, __HIP_MEMORY_SCOPE_WORKGROUP) < ph) __builtin_amdgcn_s_sleep(1);
    asm volatile("" ::: "memory");
}
constexpr int FR = 32;
constexpr int FT = 256;
__device__ __forceinline__ void filter_job(const Params& p, int job, unsigned char* lds, unsigned* hctr, unsigned& hph) {
    float* WL1 = (float*)lds; float* WL2 = WL1 + 33 * 64; float* WL3 = WL2 + 64 * 64;
    float* Z = WL3 + 64 * 64;
    float* HA = Z + FR * 33 + 32;
    float* HB = HA + FR * 64;
    const int tid = threadIdx.x, t0 = job * FR;
    const float* b1 = p.in[6]; const float* f1 = p.in[7];
    const float* b2 = p.in[9]; const float* f2 = p.in[10];
    const float* b3 = p.in[12]; const float* f3 = p.in[13];
    const float* wo = p.in[14];
    float* kraw = (float*)((unsigned char*)p.out + 64 * MiB);
    for (int e = tid; e < FR * 33; e += FT) {
        const int r = e / 33, i = e % 33; const int t = t0 + r;
        const float tn = (float)t / (float)(SEQ - 1);
        float v;
        if (i == 0) v = tn;
        else {
            const int band = (i - 1) & 15;
            const float f = 1e-4f + (float)band * ((15.0f - 1e-4f) / 15.0f);
            const float a2 = 2.0f * f * ((float)t / (float)SEQ);
            v = (i <= 16) ? cospif(a2) : -sinpif(a2);
        }
        Z[r * 33 + i] = v;
    }
    half_barrier(hctr, hph);
#pragma unroll 2
    for (int it = 0; it < FR * 64 / FT; ++it) {
        const int e = tid + it * FT, r = e >> 6, j = e & 63; float s = b1[j];
#pragma unroll 11
        for (int i = 0; i < 33; ++i) s += Z[r * 33 + i] * WL1[i * 64 + j];
        HA[r * 64 + j] = sinpif(f1[j] * s * 0.31830988618379067f);
    }
    half_barrier(hctr, hph);
#pragma unroll 2
    for (int it = 0; it < FR * 64 / FT; ++it) {
        const int e = tid + it * FT, r = e >> 6, j = e & 63; float s = b2[j];
#pragma unroll 16
        for (int i = 0; i < 64; ++i) s += HA[r * 64 + i] * WL2[i * 64 + j];
        HB[r * 64 + j] = sinpif(f2[j] * s * 0.31830988618379067f);
    }
    half_barrier(hctr, hph);
#pragma unroll 2
    for (int it = 0; it < FR * 64 / FT; ++it) {
        const int e = tid + it * FT, r = e >> 6, j = e & 63; float s = b3[j];
#pragma unroll 16
        for (int i = 0; i < 64; ++i) s += HB[r * 64 + i] * WL3[i * 64 + j];
        HA[r * 64 + j] = sinpif(f3[j] * s * 0.31830988618379067f);
    }
    half_barrier(hctr, hph);
    const float da = -3.0701134573253945f, db = -15.350567286626973f;
    typedef float f32x16 __attribute__((ext_vector_type(16)));
    const int lane = tid & 63, wave = tid >> 6, l31 = lane & 31, lh = lane >> 5;
    float af[32];
#pragma unroll
    for (int i = 0; i < 32; ++i) af[i] = HA[l31 * 64 + 2 * i + lh];
#pragma unroll 1
    for (int tile = 0; tile < 16; ++tile) {
        const int n = wave * 512 + tile * 32 + l31;
        float bv[32];
#pragma unroll
        for (int i = 0; i < 32; ++i) bv[i] = wo[(2 * i + lh) * 2048 + n];
        f32x16 acc;
#pragma unroll
        for (int i = 0; i < 16; ++i) acc[i] = 0.f;
#pragma unroll
        for (int i = 0; i < 32; ++i) acc = __builtin_amdgcn_mfma_f32_32x32x2f32(af[i], bv[i], acc, 0, 0, 0);
        const int cl = n & 1023;
        const float delta = fabsf(da + (db - da) * ((float)cl / 1023.0f));
        float* ST = (float*)(lds + 65536) + wave * (32 * 36);
#pragma unroll
        for (int i4 = 0; i4 < 4; ++i4) {
            const int tb = 8 * i4 + 4 * lh; float4 v;
            v.x = acc[4 * i4 + 0] * __expf(-((float)(t0 + tb + 0) / (float)(SEQ - 1)) * delta); v.y = acc[4 * i4 + 1] * __expf(-((float)(t0 + tb + 1) / (float)(SEQ - 1)) * delta);
            v.z = acc[4 * i4 + 2] * __expf(-((float)(t0 + tb + 2) / (float)(SEQ - 1)) * delta); v.w = acc[4 * i4 + 3] * __expf(-((float)(t0 + tb + 3) / (float)(SEQ - 1)) * delta);
            *(float4*)(ST + l31 * 36 + tb) = v;
        }
        const int nb = wave * 512 + tile * 32, half = nb >> 10, cb0 = nb & 1023;
#pragma unroll
        for (int ps = 0; ps < 4; ++ps) {
            const int rowi = ps * 8 + (lane >> 3), ch4 = (lane & 7) * 4, c = cb0 + rowi;
            const float4 v = *(const float4*)(ST + rowi * 36 + ch4);
            *(float4*)(kraw + (size_t)c * FFT_N + ((half * SEQ + t0 + ch4 + 64 * c) & (FFT_N - 1))) = v;
        }
    }
}

__device__ __forceinline__ void phase0(const Params& p, unsigned char* lds, int parts) {
    const int tid = threadIdx.x, lane = tid & 63, wave = tid >> 6, G = gridDim.x, bid = blockIdx.x;
    if (parts & 1) {
        unsigned* hctr = (unsigned*)(lds + LDS_ST_OFF) + 2;
        if (wave < 4) {
            if (bid < SEQ / FR) {
                unsigned hph = 0u;
                float* WL = (float*)lds;
                for (int i = tid; i < 33 * 64; i += FT) WL[i] = p.in[5][i];
                for (int i = tid; i < 64 * 64; i += FT) { WL[33 * 64 + i] = p.in[8][i]; WL[33 * 64 + 64 * 64 + i] = p.in[11][i]; }
                half_barrier(hctr, hph);
                for (int job = bid; job < SEQ / FR; job += G) { filter_job(p, job, lds, hctr, hph); half_barrier(hctr, hph); }
            }
        } else {
            bf16_t* hn = (bf16_t*)p.out; const float* x = p.in[0]; const float* w = p.in[1];
            int row = bid * 4 + (wave - 4); float4 nx[4], nx2[4];
#pragma unroll
            for (int i = 0; i < 4; ++i) nx[i] = *(const float4*)(x + (size_t)row * DM + i * 256 + lane * 4);
            if (row + G * 4 < MTOK) {
#pragma unroll
                for (int i = 0; i < 4; ++i) nx2[i] = *(const float4*)(x + (size_t)(row + G * 4) * DM + i * 256 + lane * 4);
            }
            for (; row < MTOK; row += G * 4) {
                float4 v[4]; float ss = 0.f;
#pragma unroll
                for (int i = 0; i < 4; ++i) { v[i] = nx[i]; nx[i] = nx2[i]; }
                const int rn = row + G * 8;
                if (rn < MTOK) {
#pragma unroll
                    for (int i = 0; i < 4; ++i) nx2[i] = *(const float4*)(x + (size_t)rn * DM + i * 256 + lane * 4);
                }
#pragma unroll
                for (int i = 0; i < 4; ++i) ss += v[i].x * v[i].x + v[i].y * v[i].y + v[i].z * v[i].z + v[i].w * v[i].w;
                ss = wave_sum(ss);
                const float r = rsqrtf(ss * (1.0f / DM) + EPSF);
#pragma unroll
                for (int i = 0; i < 4; ++i) { const float4 ww = *(const float4*)(w + i * 256 + lane * 4);
                    uint2 o; o.x = pk_bf16(v[i].x * r * ww.x, v[i].y * r * ww.y); o.y = pk_bf16(v[i].z * r * ww.z, v[i].w * r * ww.w);
                    *(uint2*)(hn + (size_t)row * DM + i * 256 + lane * 4) = o; }
            }
        }
        __syncthreads();
        if (tid == 0) *hctr = 0u;
        __syncthreads();
    }
    if (parts & 2) weight_transposes(p, lds);
    if (parts & 2) { bf16_t* sgw = (bf16_t*)(p.ws + WS_SGW); const float* s = p.in[18];
      for (int i = bid * NT + tid; i < 8 * 128 * 128; i += G * NT) sgw[i] = f2bf(s[i]);
      cf* tw = (cf*)(p.ws + WS_TW);
      for (int i = bid * NT + tid; i < 2048; i += G * NT) { float sn, cs; sincospif(-2.0f * (float)i / (float)FFT_N, &sn, &cs); tw[i] = cf{cs, sn}; } }
}

struct EpiHyT {
    static constexpr bool PERM = false, AFTER_DRAIN = false, SWAP = true;
    bf16_t* O;
    unsigned char* st;
    __device__ __forceinline__ void operator()(const pg8::f32x4 (&acc)[2][2][4][2], const pg8::Unit& u, int wr, int wc, int fr, int fq) const {
        const int lane = fq * 16 + fr;
        unsigned char* S = st + (wr * 4 + wc) * 2304;
        const int row0 = u.pm * 256 + wr * 64, b = row0 >> 13, tb = row0 & (SEQ - 1);
        const int rrow = lane >> 3, rchk = lane & 7;
#pragma unroll
        for (int ai = 0; ai < 2; ++ai)
#pragma unroll
            for (int bj = 0; bj < 2; ++bj)
#pragma unroll
                for (int n = 0; n < 2; ++n) {
#pragma unroll
                    for (int m = 0; m < 4; ++m) { const pg8::f32x4 v = acc[ai][bj][m][n]; uint2 o; o.x = pk_bf16(v[0], v[1]); o.y = pk_bf16(v[2], v[3]);
                        *(uint2*)(S + fr * 144 + (16 * m + 4 * fq) * 2) = o; }
#pragma unroll
                    for (int ps = 0; ps < 2; ++ps) { const int r = ps * 8 + rrow; const uint4 v = *(const uint4*)(S + r * 144 + rchk * 16);
                        const int ch = u.pn * 256 + bj * 128 + wc * 32 + n * 16 + r;
                        *(uint4*)(O + ((size_t)b * NHY + ch) * SEQ + tb + ai * 128 + rchk * 8) = v; }
                }
    }
};

struct EpiSg {
    static constexpr bool PERM = true, AFTER_DRAIN = false, SWAP = false;
    bf16_t* O;
    __device__ __forceinline__ void operator()(const pg8::f32x4 (&acc)[2][2][4][2], const pg8::Unit& u, int wr, int wc, int fr, int fq) const {
        const int row0 = u.pm * 256 + wr * 64 + fr;
        if (u.pn < 8) {
            const int col0 = u.pn * 128 + wc * 32 + 8 * fq;
#pragma unroll
            for (int ai = 0; ai < 2; ++ai)
#pragma unroll
                for (int m = 0; m < 4; ++m) { bf16_t* rowp = O + (size_t)(row0 + ai * 128 + m * 16) * NSG + col0;
                    const pg8::f32x4 u0 = acc[ai][0][m][0], u1 = acc[ai][0][m][1], g0 = acc[ai][1][m][0], g1 = acc[ai][1][m][1];
                    uint4 w; w.x = pk_bf16(u0[0] * siluf(g0[0]), u0[1] * siluf(g0[1])); w.y = pk_bf16(u0[2] * siluf(g0[2]), u0[3] * siluf(g0[3]));
                    w.z = pk_bf16(u1[0] * siluf(g1[0]), u1[1] * siluf(g1[1])); w.w = pk_bf16(u1[2] * siluf(g1[2]), u1[3] * siluf(g1[3]));
                    *(uint4*)rowp = w; }
        } else {
            const int col0 = 1024 + (u.pn - 8) * 256 + wc * 32 + 8 * fq;
#pragma unroll
            for (int ai = 0; ai < 2; ++ai)
#pragma unroll
                for (int m = 0; m < 4; ++m) { bf16_t* rowp = O + (size_t)(row0 + ai * 128 + m * 16) * NSG + col0;
#pragma unroll
                    for (int bj = 0; bj < 2; ++bj) { const pg8::f32x4 v0 = acc[ai][bj][m][0], v1 = acc[ai][bj][m][1];
                        uint4 w; w.x = pk_bf16(v0[0], v0[1]); w.y = pk_bf16(v0[2], v0[3]); w.z = pk_bf16(v1[0], v1[1]); w.w = pk_bf16(v1[2], v1[3]);
                        *(uint4*)(rowp + bj * 128) = w; } }
        }
    }
};

__device__ __forceinline__ void lds_barrier() { asm volatile("s_waitcnt lgkmcnt(0)" ::: "memory"); __builtin_amdgcn_s_barrier(); asm volatile("" ::: "memory"); }
template <int MODE>
__device__ __forceinline__ void fft_fwd3(cf* X, const cf* tw, int tid) {
    fft_stage<32, false, 512, 1, MODE>(X, tw, tid, NT); lds_barrier();
    fft_stage<32, false, 16, 32>(X, tw, tid, NT); lds_barrier();
}
__device__ __forceinline__ void fft_inv3(cf* X, const cf* tw, int tid) {
    fft_stage<32, true, 16, 32>(X, tw, tid, NT); lds_barrier();
    fft_stage<32, true, 512, 1, 2>(X, tw, tid, NT); lds_barrier();
}
struct Raw8 { uint4 q; bf16_t lo, hi; };
__device__ __forceinline__ Raw8 load_raw8(const bf16_t* row, int t0) {
    const int lane = threadIdx.x & 63;
    Raw8 r; r.q = *(const uint4*)(row + t0); r.lo = (bf16_t)0; r.hi = (bf16_t)0;
    if (lane == 0 && t0 > 0) r.lo = row[t0 - 1];
    if (lane == 63 && t0 + 8 < SEQ) r.hi = row[t0 + 8];
    return r;
}
__device__ __forceinline__ void conv8r(const Raw8& r, float w0, float w1, float w2, float bias, float (&o)[8]) {
    const int lane = threadIdx.x & 63;
    const unsigned prev = __shfl_up(r.q.w >> 16, 1), next = __shfl_down(r.q.x & 0xffffu, 1);
    float v[10];
    v[0] = __uint_as_float((lane == 0 ? (unsigned)r.lo : prev) << 16);
    v[1] = bf_lo(r.q.x); v[2] = bf_hi(r.q.x); v[3] = bf_lo(r.q.y); v[4] = bf_hi(r.q.y); v[5] = bf_lo(r.q.z); v[6] = bf_hi(r.q.z); v[7] = bf_lo(r.q.w); v[8] = bf_hi(r.q.w);
    v[9] = __uint_as_float((lane == 63 ? (unsigned)r.hi : next) << 16);
#pragma unroll
    for (int j = 0; j < 8; ++j) o[j] = v[j] * w0 + v[j + 1] * w1 + v[j + 2] * w2 + bias;
}
struct RawU { Raw8 v0[2], x0[2], v1[2], x1[2]; };
__device__ __forceinline__ void hyena_job(const Params& p, int c, unsigned char* lds, bool dry = false) {
    cf* X = (cf*)lds; float* red = (float*)(lds + FFT_LDS_CF * 8);
    const int tid = threadIdx.x, lane = tid & 63, wave = tid >> 6;
    const cf* tw = (const cf*)(lds + FFT_LDS_CF * 8 + 1024);
    bf16_t* HYT = (bf16_t*)(p.ws + WS_HYT);
    const float* cw = p.in[3]; const float* cb = p.in[4];
    typedef unsigned u32x4k __attribute__((ext_vector_type(4)));
    float4* ks = (float4*)(p.ws + WS_KSCR) + (size_t)blockIdx.x * (FFT_N / 2);
    const __amdgpu_buffer_rsrc_t ks_rsrc = __builtin_amdgcn_make_buffer_rsrc((void*)ks, 0, FFT_N * 8, 0x00020000);
    RawU ru;
#define LOAD_RU(PAIR) do { const bf16_t* _v0 = HYT + ((size_t)(2 * (PAIR)) * NHY + 2048 + c) * SEQ; const bf16_t* _v1 = _v0 + (size_t)NHY * SEQ; \
        const bf16_t* _x0 = HYT + ((size_t)(2 * (PAIR)) * NHY + 1024 + c) * SEQ; const bf16_t* _x1 = _x0 + (size_t)NHY * SEQ; \
        _Pragma("unroll") for (int it = 0; it < 2; ++it) { const int t0 = (tid + it * NT) * 8; \
            ru.v0[it] = load_raw8(_v0, t0); ru.x0[it] = load_raw8(_x0, t0); ru.v1[it] = load_raw8(_v1, t0); ru.x1[it] = load_raw8(_x1, t0); } } while (0)
    LOAD_RU(0);
    { const float* kr = (const float*)((const unsigned char*)p.out + 64 * MiB) + (size_t)c * FFT_N;
      float4 kv[8];
#pragma unroll
      for (int it = 0; it < 8; ++it) kv[it] = *(const float4*)(kr + ((tid * 4 + it * (NT * 4) + 64 * c) & (FFT_N - 1)));
      float l1 = 0.f;
#pragma unroll
      for (int it = 0; it < 8; ++it) { const float4 v = kv[it]; const int i = tid * 4 + it * (NT * 4);
          if (it < 4) {
              l1 += fabsf(v.x) + fabsf(v.y) + fabsf(v.z) + fabsf(v.w);
              const int pi = PADI(i); X[pi] = cf{v.x, 0.f}; X[pi + 1] = cf{v.y, 0.f}; X[pi + 2] = cf{v.z, 0.f}; X[pi + 3] = cf{v.w, 0.f};
          } else {
              const int m = i - SEQ;
              l1 += (m == 0 ? 0.f : fabsf(v.x)) + fabsf(v.y) + fabsf(v.z) + fabsf(v.w);
              X[PADI(m == 0 ? SEQ : FFT_N - m)] = cf{m == 0 ? 0.f : v.x, 0.f};
              const int pb = PADI(FFT_N - m - 3); X[pb + 2] = cf{v.y, 0.f}; X[pb + 1] = cf{v.z, 0.f}; X[pb] = cf{v.w, 0.f};
          } }
      l1 = wave_sum(l1); if (lane == 0) red[wave] = l1;
      lds_barrier();
      float tot = 0.f;
#pragma unroll
      for (int i = 0; i < 8; ++i) tot += red[i];
      fft_fwd3<0>(X, tw, tid);
      const float sc = 1.0f / ((tot + EPSF) * (float)FFT_N), sk = p.in[15][c] * (1.0f / (float)FFT_N);
#pragma unroll 1
      for (int g = tid; g < FFT_N / 16; g += NT) {
          const int pb = PADI(g * 16); cf a[16];
#pragma unroll
          for (int j = 0; j < 16; ++j) a[j] = X[pb + j];
          dft16<false>(a);
#pragma unroll
          for (int j = 0; j < 16; j += 2) (ks + (j >> 1) * (FFT_N / 16))[(unsigned)g] = make_float4(a[j].x * sc + sk, a[j].y * sc, a[j + 1].x * sc + sk, a[j + 1].y * sc);
      }
      asm volatile("s_waitcnt vmcnt(0)" ::: "memory");
      __syncthreads();
    }
    const float x0w0 = cw[c], x0w1 = cw[3072 + c], x0w2 = cw[6144 + c], x0b = cb[c];
    const float x1w0 = cw[1024 + c], x1w1 = cw[3072 + 1024 + c], x1w2 = cw[6144 + 1024 + c], x1b = cb[1024 + c];
    const float vw0 = cw[2048 + c], vw1 = cw[3072 + 2048 + c], vw2 = cw[6144 + 2048 + c], vb = cb[2048 + c];
#pragma unroll
    for (int pair = 0; pair < 2; ++pair) {
        const int b0 = 2 * pair, b1 = b0 + 1;
        bf16_t* vr0 = HYT + ((size_t)b0 * NHY + 2048 + c) * SEQ; bf16_t* vr1 = HYT + ((size_t)b1 * NHY + 2048 + c) * SEQ;
        bf16_t* yo0 = dry ? (bf16_t*)p.out + ((size_t)b0 * 1024 + c) * SEQ : vr0; bf16_t* yo1 = dry ? (bf16_t*)p.out + ((size_t)b1 * 1024 + c) * SEQ : vr1;
        {
#pragma unroll
            for (int it = 0; it < 2; ++it) { const int t0 = (tid + it * NT) * 8; float a[8], b[8], u0[8], u1[8];
                conv8r(ru.v0[it], vw0, vw1, vw2, vb, a); conv8r(ru.x0[it], x1w0, x1w1, x1w2, x1b, b);
#pragma unroll
                for (int j = 0; j < 8; ++j) u0[j] = a[j] * b[j];
                conv8r(ru.v1[it], vw0, vw1, vw2, vb, a); conv8r(ru.x1[it], x1w0, x1w1, x1w2, x1b, b);
#pragma unroll
                for (int j = 0; j < 8; ++j) u1[j] = a[j] * b[j];
                const int pi = PADI(t0);
#pragma unroll
                for (int j = 0; j < 8; ++j) X[pi + j] = cf{u0[j], u1[j]}; }
        }
        lds_barrier();
        fft_fwd3<1>(X, tw, tid);
        {
#pragma unroll 1
            for (int h = 0; h < 2; ++h) {
                const unsigned g = (unsigned)(tid + h * NT);
                float4 kk[8];
#pragma unroll
                for (int q = 0; q < 8; ++q) { const u32x4k t = __builtin_amdgcn_raw_buffer_load_b128(ks_rsrc, (unsigned)((q * (FFT_N / 16) + g) * 16), 0, 16); kk[q] = make_float4(__uint_as_float(t.x), __uint_as_float(t.y), __uint_as_float(t.z), __uint_as_float(t.w)); }
                const int pb = PADI((int)g * 16); cf a[16], b[16];
#pragma unroll
                for (int j = 0; j < 16; ++j) a[j] = X[pb + j];
                dft16<false>(a);
#pragma unroll
                for (int j = 0; j < 16; ++j) { const float4 k4 = kk[j >> 1]; const cf k = (j & 1) ? cf{k4.z, k4.w} : cf{k4.x, k4.y}; b[KIDX<16>(j)] = cmul(a[j], k); }
                dft16<true>(b);
#pragma unroll
                for (int j = 0; j < 16; ++j) X[pb + KIDX<16>(j)] = b[j];
            }
        }
        const bf16_t* x0r0 = HYT + ((size_t)b0 * NHY + c) * SEQ; const bf16_t* x0r1 = HYT + ((size_t)b1 * NHY + c) * SEQ;
        const bf16_t* gr0 = HYT + ((size_t)b0 * NHY + 3072 + c) * SEQ; const bf16_t* gr1 = HYT + ((size_t)b1 * NHY + 3072 + c) * SEQ;
        Raw8 r0[2], r1[2]; uint4 g0[2], g1[2];
#pragma unroll
        for (int it = 0; it < 2; ++it) { const int t0 = (tid + it * NT) * 8;
            r0[it] = load_raw8(x0r0, t0); r1[it] = load_raw8(x0r1, t0); g0[it] = *(const uint4*)(gr0 + t0); g1[it] = *(const uint4*)(gr1 + t0); }
        lds_barrier();
        fft_inv3(X, tw, tid);
        if (pair == 0) LOAD_RU(1);
        {
#pragma unroll
            for (int it = 0; it < 2; ++it) { const int t0 = (tid + it * NT) * 8, pi = PADI(t0); float a[8], y[8];
                { conv8r(r0[it], x0w0, x0w1, x0w2, x0b, a); const uint4 g = g0[it];
                  const float gg[8] = {bf_lo(g.x), bf_hi(g.x), bf_lo(g.y), bf_hi(g.y), bf_lo(g.z), bf_hi(g.z), bf_lo(g.w), bf_hi(g.w)};
#pragma unroll
                  for (int j = 0; j < 8; ++j) y[j] = a[j] * X[pi + j].x * siluf(gg[j]);
                  uint4 o; o.x = pk_bf16(y[0], y[1]); o.y = pk_bf16(y[2], y[3]); o.z = pk_bf16(y[4], y[5]); o.w = pk_bf16(y[6], y[7]);
                  *(uint4*)(yo0 + t0) = o; }
                { conv8r(r1[it], x0w0, x0w1, x0w2, x0b, a); const uint4 g = g1[it];
                  const float gg[8] = {bf_lo(g.x), bf_hi(g.x), bf_lo(g.y), bf_hi(g.y), bf_lo(g.z), bf_hi(g.z), bf_lo(g.w), bf_hi(g.w)};
#pragma unroll
                  for (int j = 0; j < 8; ++j) y[j] = a[j] * X[pi + j].y * siluf(gg[j]);
                  uint4 o; o.x = pk_bf16(y[0], y[1]); o.y = pk_bf16(y[2], y[3]); o.z = pk_bf16(y[4], y[5]); o.w = pk_bf16(y[6], y[7]);
                  *(uint4*)(yo1 + t0) = o; } }
        }
        lds_barrier();
    }
}

#undef LOAD_RU
__device__ __forceinline__ uint4 gmlp_group(const bf16_t* vnT, const bf16x8 (&wf)[4], int g, int fr, int fq, float bias, uint4 u4) {
    constexpr int PITCH = 136;
    f32x4 acc0 = (f32x4){0.f, 0.f, 0.f, 0.f}, acc1 = (f32x4){0.f, 0.f, 0.f, 0.f};
    const int drow = 32 * g + 8 * (fr >> 2) + (fr & 3);
#pragma unroll
    for (int ks = 0; ks < 4; ++ks) { const int kq = (ks * 32 + fq * 8) ^ ((fr >> 2) << 4);
        const bf16x8 v0 = *(const bf16x8*)(vnT + drow * PITCH + kq), v1 = *(const bf16x8*)(vnT + (drow + 4) * PITCH + kq);
        acc0 = __builtin_amdgcn_mfma_f32_16x16x32_bf16(v0, wf[ks], acc0, 0, 0, 0); acc1 = __builtin_amdgcn_mfma_f32_16x16x32_bf16(v1, wf[ks], acc1, 0, 0, 0); }
    const float y0 = bf_lo(u4.x) * (acc0[0] + bias), y1 = bf_hi(u4.x) * (acc0[1] + bias), y2 = bf_lo(u4.y) * (acc0[2] + bias), y3 = bf_hi(u4.y) * (acc0[3] + bias);
    const float y4 = bf_lo(u4.z) * (acc1[0] + bias), y5 = bf_hi(u4.z) * (acc1[1] + bias), y6 = bf_lo(u4.w) * (acc1[2] + bias), y7 = bf_hi(u4.w) * (acc1[3] + bias);
    uint4 o; o.x = pk_bf16(y0, y1); o.y = pk_bf16(y2, y3); o.z = pk_bf16(y4, y5); o.w = pk_bf16(y6, y7);
    return o;
}
__device__ __forceinline__ uint4 swap8(uint4 v) {
    uint4 r; r.x = (unsigned)__shfl_xor((int)v.x, 8); r.y = (unsigned)__shfl_xor((int)v.y, 8); r.z = (unsigned)__shfl_xor((int)v.z, 8); r.w = (unsigned)__shfl_xor((int)v.w, 8); return r;
}
__device__ __forceinline__ uint4 sel4(bool c, uint4 a, uint4 b) { uint4 r; r.x = c ? a.x : b.x; r.y = c ? a.y : b.y; r.z = c ? a.z : b.z; r.w = c ? a.w : b.w; return r; }
__device__ __forceinline__ void gmlp_phase(const Params& p, unsigned char* lds, bool dry, int k0 = 0, int nk = 1 << 20) {
    constexpr int PITCH = 136;
    bf16_t* SG = (bf16_t*)(p.ws + WS_SG);
    const bf16_t* sgw = (const bf16_t*)(p.ws + WS_SGW);
    const int tid = threadIdx.x, lane = tid & 63, wave = tid >> 6, G = gridDim.x;
    const int q = tid >> 2, part = tid & 3;
    const int qs = q ^ (part << 4);
    const int fr = lane & 15, fq = lane >> 4, p0 = wave * 16;
    int j = blockIdx.x + G * k0;
    const int jmax = min(2048, (int)blockIdx.x + (nk >= (1 << 20) ? (1 << 24) : G * (k0 + nk)));
    if (j >= jmax) return;
    uint4 vq[4];
    { const bf16_t* src = SG + ((size_t)(j >> 3) * 128 + q) * NSG + 1024 + (j & 7) * 128 + part * 8;
#pragma unroll
      for (int i = 0; i < 4; ++i) vq[i] = *(const uint4*)(src + i * 32); }
    int buf = 0;
#pragma unroll 1
    for (; j < jmax; j += G, buf ^= 1) {
        const int chunk = j >> 3, h = j & 7;
        const size_t t0 = (size_t)chunk * 128;
        bf16_t* vnT = (bf16_t*)(lds + buf * (128 * PITCH * 2));
        uint4 la[2], lb[2]; bf16x8 wf[4];
        const int r7 = fr & 7, hi = fr >> 3;
        const size_t rowA = (t0 + p0 + r7) * NSG, rowB = rowA + 8 * (size_t)NSG;
#pragma unroll
        for (int gp = 0; gp < 2; ++gp) { const int d = h * 128 + 32 * (2 * gp + hi) + 8 * fq; la[gp] = *(const uint4*)(SG + rowA + d); lb[gp] = *(const uint4*)(SG + rowB + d); }
#pragma unroll
        for (int ks = 0; ks < 4; ++ks) wf[ks] = *(const bf16x8*)(sgw + ((size_t)h * 128 + p0 + fr) * 128 + ks * 32 + fq * 8);
        const float bias = p.in[19][h * 128 + p0 + fr];
        {
            float v[32];
#pragma unroll
            for (int i = 0; i < 4; ++i) { const uint4 w = vq[i];
                v[8 * i + 0] = bf_lo(w.x); v[8 * i + 1] = bf_hi(w.x); v[8 * i + 2] = bf_lo(w.y); v[8 * i + 3] = bf_hi(w.y);
                v[8 * i + 4] = bf_lo(w.z); v[8 * i + 5] = bf_hi(w.z); v[8 * i + 6] = bf_lo(w.w); v[8 * i + 7] = bf_hi(w.w); }
            const int jn = j + G;
            if (jn < jmax) { const bf16_t* src = SG + ((size_t)(jn >> 3) * 128 + q) * NSG + 1024 + (jn & 7) * 128 + part * 8;
#pragma unroll
                for (int i = 0; i < 4; ++i) vq[i] = *(const uint4*)(src + i * 32); }
            float s = 0.f;
#pragma unroll
            for (int i = 0; i < 32; ++i) s += v[i];
            s += __shfl_xor(s, 1); s += __shfl_xor(s, 2);
            const float mu = s * (1.0f / 128.0f);
            float qq = 0.f;
#pragma unroll
            for (int i = 0; i < 32; ++i) { const float d = v[i] - mu; qq += d * d; }
            qq += __shfl_xor(qq, 1); qq += __shfl_xor(qq, 2);
            const float rstd = rsqrtf(qq * (1.0f / 128.0f) + EPSF);
            const float* nw = p.in[16] + h * 128 + part * 8; const float* nb = p.in[17] + h * 128 + part * 8;
#pragma unroll
            for (int i = 0; i < 32; i += 4) { const int dd = 32 * (i >> 3) + (i & 7); const float4 w4 = *(const float4*)(nw + dd), b4 = *(const float4*)(nb + dd);
                vnT[(part * 8 + dd + 0) * PITCH + qs] = f2bf((v[i + 0] - mu) * rstd * w4.x + b4.x); vnT[(part * 8 + dd + 1) * PITCH + qs] = f2bf((v[i + 1] - mu) * rstd * w4.y + b4.y);
                vnT[(part * 8 + dd + 2) * PITCH + qs] = f2bf((v[i + 2] - mu) * rstd * w4.z + b4.z); vnT[(part * 8 + dd + 3) * PITCH + qs] = f2bf((v[i + 3] - mu) * rstd * w4.w + b4.w); }
        }
        lds_barrier();
#pragma unroll
        for (int gp = 0; gp < 2; ++gp) {
            const bool hb = hi != 0;
            const uint4 rcv = swap8(sel4(hb, la[gp], lb[gp]));
            const uint4 u0 = sel4(hb, rcv, la[gp]), u1 = sel4(hb, lb[gp], rcv);
            const uint4 yo0 = gmlp_group(vnT, wf, 2 * gp, fr, fq, bias, u0), yo1 = gmlp_group(vnT, wf, 2 * gp + 1, fr, fq, bias, u1);
            const uint4 rcv2 = swap8(sel4(hb, yo0, yo1));
            const uint4 oa = sel4(hb, rcv2, yo0), ob = sel4(hb, yo1, rcv2);
            const int d = h * 128 + 32 * (2 * gp + hi) + 8 * fq;
            if (dry) { *(uint4*)((bf16_t*)p.out + (t0 + p0 + r7) * 1024 + d) = oa; *(uint4*)((bf16_t*)p.out + (t0 + p0 + 8 + r7) * 1024 + d) = ob; }
            else { *(uint4*)(SG + rowA + d) = oa; *(uint4*)(SG + rowB + d) = ob; }
        }
    }
    __syncthreads();
}

__device__ __forceinline__ void ya_transpose_phase(const Params& p, unsigned char* lds) {
    const bf16_t* HYT = (const bf16_t*)(p.ws + WS_HYT); bf16_t* SG = (bf16_t*)(p.ws + WS_SG);
    const int tid = threadIdx.x, G = gridDim.x;
    const int c = tid >> 3, tc = (tid & 7) * 8;
    int tile = blockIdx.x, buf = 0;
    if (tile >= 8192) return;
#define YA_SRC(t) (HYT + ((size_t)((t) >> 11) * NHY + 2048 + (((t) >> 7) & 15) * 64 + c) * SEQ + ((t) & 127) * 64 + tc)
    uint4 v = *(const uint4*)YA_SRC(tile);
    for (; tile < 8192; tile += G, buf ^= 1) {
        bf16_t* T = (bf16_t*)lds + buf * (64 * 72);
        T[(tc + 0) * 72 + c] = (bf16_t)(v.x & 0xffff); T[(tc + 1) * 72 + c] = (bf16_t)(v.x >> 16); T[(tc + 2) * 72 + c] = (bf16_t)(v.y & 0xffff); T[(tc + 3) * 72 + c] = (bf16_t)(v.y >> 16);
        T[(tc + 4) * 72 + c] = (bf16_t)(v.z & 0xffff); T[(tc + 5) * 72 + c] = (bf16_t)(v.z >> 16); T[(tc + 6) * 72 + c] = (bf16_t)(v.w & 0xffff); T[(tc + 7) * 72 + c] = (bf16_t)(v.w >> 16);
        const int tn = tile + G;
        if (tn < 8192) v = *(const uint4*)YA_SRC(tn);
        lds_barrier();
        const int tt = tile & 127, ct = (tile >> 7) & 15, b = tile >> 11;
        { const int t = tid >> 3, cc = (tid & 7) * 8;
          const uint4 o = *(const uint4*)(T + t * 72 + cc);
          *(uint4*)(SG + ((size_t)b * SEQ + tt * 64 + t) * NSG + 1024 + ct * 64 + cc) = o; }
    }
#undef YA_SRC
    lds_barrier();
}

__device__ __forceinline__ void phase5(const Params& p) {
    const int tid = threadIdx.x, lane = tid & 63, wave = tid >> 6, G = gridDim.x, bid = blockIdx.x;
    const float* x = p.in[0]; const float* w = p.in[21]; float* out = p.out;
    const bf16_t* Y = (const bf16_t*)(p.ws + WS_HYT);
    float4 ww[4];
#pragma unroll
    for (int i = 0; i < 2; ++i)
#pragma unroll
        for (int hh = 0; hh < 2; ++hh) ww[i * 2 + hh] = *(const float4*)(w + i * 512 + lane * 8 + hh * 4);
    int row = bid * 8 + wave;
    uint4 nq[2]; float4 nxx[4];
#pragma unroll
    for (int i = 0; i < 2; ++i) { nq[i] = *(const uint4*)(Y + (size_t)row * DM + i * 512 + lane * 8);
#pragma unroll
        for (int hh = 0; hh < 2; ++hh) nxx[i * 2 + hh] = *(const float4*)(x + (size_t)row * DM + i * 512 + lane * 8 + hh * 4); }
    for (; row < MTOK; row += G * 8) {
        float* orow = out + (size_t)row * DM;
        uint4 q[2]; float4 xx[4]; float v[2][8]; float ss = 0.f;
#pragma unroll
        for (int i = 0; i < 2; ++i) q[i] = nq[i];
#pragma unroll
        for (int i = 0; i < 4; ++i) xx[i] = nxx[i];
        const int rn = row + G * 8;
        if (rn < MTOK) {
#pragma unroll
            for (int i = 0; i < 2; ++i) { nq[i] = *(const uint4*)(Y + (size_t)rn * DM + i * 512 + lane * 8);
#pragma unroll
                for (int hh = 0; hh < 2; ++hh) nxx[i * 2 + hh] = *(const float4*)(x + (size_t)rn * DM + i * 512 + lane * 8 + hh * 4); }
        }
#pragma unroll
        for (int i = 0; i < 2; ++i) { v[i][0] = bf_lo(q[i].x); v[i][1] = bf_hi(q[i].x); v[i][2] = bf_lo(q[i].y); v[i][3] = bf_hi(q[i].y);
            v[i][4] = bf_lo(q[i].z); v[i][5] = bf_hi(q[i].z); v[i][6] = bf_lo(q[i].w); v[i][7] = bf_hi(q[i].w);
#pragma unroll
            for (int j = 0; j < 8; ++j) ss += v[i][j] * v[i][j]; }
        ss = wave_sum(ss);
        const float r = rsqrtf(ss * (1.0f / DM) + EPSF);
#pragma unroll
        for (int i = 0; i < 2; ++i)
#pragma unroll
            for (int hh = 0; hh < 2; ++hh) { const int col = i * 512 + lane * 8 + hh * 4; const float4 wq = ww[i * 2 + hh], xq = xx[i * 2 + hh];
                float4 o; o.x = xq.x + v[i][hh * 4 + 0] * r * wq.x; o.y = xq.y + v[i][hh * 4 + 1] * r * wq.y; o.z = xq.z + v[i][hh * 4 + 2] * r * wq.z; o.w = xq.w + v[i][hh * 4 + 3] * r * wq.w;
                *(float4*)(orow + col) = o; }
    }
}

__global__ void __launch_bounds__(NT, 2) hyena_gmlp_fwd(Params p) {
    extern __shared__ __attribute__((aligned(16))) unsigned char lds[];
    cg::grid_group grid = cg::this_grid();
    const int G = gridDim.x, bid = blockIdx.x;
    PG8_LAS unsigned char* ldsl = (PG8_LAS unsigned char*)lds;
    if (threadIdx.x < 4) ((unsigned*)(lds + LDS_ST_OFF))[threadIdx.x] = 0u;
    __syncthreads();
    if (bid == 0) { unsigned* bw = (unsigned*)(p.ws + WS_BAR); for (int i = threadIdx.x; i < XCD_BAR_WORDS; i += NT) bw[i] = 0u; }

    phase0(p, lds, 7);
#if PROBE_REP == 21
    phase0(p, lds, 1);
#elif PROBE_REP == 22
    phase0(p, lds, 2);
#elif PROBE_REP == 23
    phase0(p, lds, 4);
#elif PROBE_REP == 1
    phase0(p, lds, 7);
#endif
    grid.sync();
    const XcdBarrier xbar = xcd_barrier_post((unsigned*)(p.ws + WS_BAR), (volatile XB_LAS unsigned*)(lds + LDS_ST_OFF));

#pragma unroll 1
    for (int rep = 0; rep < NREP(2); ++rep) {
        pg8::Gemm g{(const bf16_t*)p.out, (const bf16_t*)(p.ws + WS_W1T), MTOK, NHY, DM, DM};
        pg8::StaticOrder S; S.init(MTOK, NHY, G, bid);
        EpiHyT E{(bf16_t*)(p.ws + WS_HYT), lds + 131072};
        pg8::gemm_phase<EpiHyT, pg8::StaticOrder, GEMM_ALIGN, GEMM_SP2>(ldsl, g, S, E);
#if PROBE_REP == 12
        pg8::gemm_phase<EpiHyT, pg8::StaticOrder, GEMM_ALIGN, GEMM_SP2>(ldsl, g, S, E);
#endif
    }
#pragma unroll 1
    for (int rep = 0; rep < NREP(3); ++rep) {
        pg8::Gemm g{(const bf16_t*)p.out, (const bf16_t*)(p.ws + WS_W1T) + (size_t)NHY * DM, MTOK, NSG, DM, DM};
        pg8::StaticOrder S; S.init(MTOK, NSG, G, bid);
        EpiSg E{(bf16_t*)(p.ws + WS_SG)};
        pg8::gemm_phase<EpiSg, pg8::StaticOrder, GEMM_ALIGN, GEMM_SP2>(ldsl, g, S, E);
#if PROBE_REP == 13
        pg8::gemm_phase<EpiSg, pg8::StaticOrder, GEMM_ALIGN, GEMM_SP2>(ldsl, g, S, E);
#endif
    }
    xcd_barrier(xbar);

    { const cf* twg = (const cf*)(p.ws + WS_TW); cf* twl = (cf*)(lds + FFT_LDS_CF * 8 + 1024);
      for (int i = threadIdx.x; i < 2048; i += NT) twl[i] = twg[i];
      __syncthreads(); }
#if PROBE_REP == 4 || PROBE_REP == 5
#pragma unroll 1
    for (int rep = 0; rep < NREP(4); ++rep)
        for (int c = bid; c < 1024; c += G) hyena_job(p, c, lds, rep < NREP(4) - 1);
#pragma unroll 1
    for (int rep = 0; rep < NREP(5); ++rep)
        gmlp_phase(p, lds, rep < NREP(5) - 1);
#else
    {
        const int nhy = (1024 - bid + G - 1) / G, ngm = (2048 - bid + G - 1) / G;
        const int gper = (ngm + nhy - 1) / (nhy > 0 ? nhy : 1);
        const bool first = ((bid >> 3) & 1) != 0;
#pragma unroll 1
        for (int e = 0; e <= nhy; ++e) {
            int k0, nk;
            if (first) { k0 = e * gper; nk = (e < nhy) ? gper : ngm - k0; }
            else { k0 = (e - 1) * gper; nk = (e == 0) ? 0 : ((e < nhy) ? gper : ngm - k0); }
            if (nk > 0) gmlp_phase(p, lds, false, k0, nk);
            if (e < nhy) hyena_job(p, bid + G * e, lds, false);
        }
    }
#endif
    xcd_barrier(xbar);

#pragma unroll 1
    for (int rep = 0; rep < NREP(6); ++rep)
        ya_transpose_phase(p, lds);
    xcd_barrier(xbar);

#pragma unroll 1
    for (int rep = 0; rep < NREP(7); ++rep) {
        pg8::Gemm g{(const bf16_t*)(p.ws + WS_SG), (const bf16_t*)(p.ws + WS_W2T), MTOK, DM, 2048, NSG};
        pg8::StaticOrder S; S.init(MTOK, DM, G, bid);
        pg8::EpiBf16<0> E{(bf16_t*)(p.ws + WS_HYT), DM, nullptr, 0, 0};
        pg8::gemm_phase<pg8::EpiBf16<0>, pg8::StaticOrder, GEMM_ALIGN, GEMM_SP2>(ldsl, g, S, E);
#if PROBE_REP == 17
        pg8::gemm_phase<pg8::EpiBf16<0>, pg8::StaticOrder, GEMM_ALIGN, GEMM_SP2>(ldsl, g, S, E);
#endif
    }
    xcd_barrier(xbar);

#pragma unroll 1
    for (int rep = 0; rep < NREP(8); ++rep) phase5(p);
#if PROBE_REP == 9
    grid.sync(); grid.sync(); grid.sync(); grid.sync();
#endif
}

extern "C" void kernel_launch(void* const* d_in, const int* in_sizes, int n_in, void* d_out, int out_size, void* d_ws, size_t ws_size, hipStream_t stream) {
    static int grid_blocks = 0;
    if (grid_blocks == 0) {
        if (n_in != 22 || out_size != MTOK * DM || ws_size < WS_END) { fprintf(stderr, "kernel_launch: unexpected shapes (n_in %d out %d ws %zu need %zu)\n", n_in, out_size, ws_size, (size_t)WS_END); grid_blocks = -1; return; }
        int dev = 0, cus = 0, per_cu = 0;
        hipGetDevice(&dev);
        hipDeviceGetAttribute(&cus, hipDeviceAttributeMultiprocessorCount, dev);
        if (hipFuncSetAttribute((const void*)hyena_gmlp_fwd, hipFuncAttributeMaxDynamicSharedMemorySize, LDS_BYTES) != hipSuccess) { fprintf(stderr, "kernel_launch: hipFuncSetAttribute failed\n"); grid_blocks = -1; return; }
        if (hipOccupancyMaxActiveBlocksPerMultiprocessor(&per_cu, (const void*)hyena_gmlp_fwd, NT, LDS_BYTES) != hipSuccess || per_cu < 1) { fprintf(stderr, "kernel_launch: occupancy query says %d\n", per_cu); (void)hipGetLastError(); grid_blocks = -1; return; }
        grid_blocks = cus * per_cu;
        if (grid_blocks > 256) grid_blocks = 256;
    }
    if (grid_blocks < 0) return;
    Params p{};
    for (int i = 0; i < 22; ++i) p.in[i] = (const float*)d_in[i];
    p.out = (float*)d_out; p.ws = (unsigned char*)d_ws;
    void* args[] = {&p};
    hipError_t e = hipLaunchCooperativeKernel((const void*)hyena_gmlp_fwd, dim3(grid_blocks), dim3(NT), args, LDS_BYTES, stream);
    if (e != hipSuccess) fprintf(stderr, "cooperative launch failed: %s (grid %d)\n", hipGetErrorString(e), grid_blocks);
}
```
